# Optimizing an MI355X kernel written in HIP

```python
import jax, jax.numpy as jnp
from jax import lax
import numpy as np

D_MODEL = 1024
BATCH = 2
SEQ = 8192
DEPTH = 1

D_CONV = D_MODEL
CONV_WIDTH = 3
HEAD_DIM = 64
HEADS_PER_GROUP = 8
GROUPS = ((128, 1), (512, 4), (2048, 16))
N_GROUPS = len(GROUPS)
N_ATT_HEADS = N_GROUPS * HEADS_PER_GROUP
ATT_GROUP_W = HEADS_PER_GROUP * HEAD_DIM
ATT_QKV_W = N_GROUPS * ATT_GROUP_W
D_FF = 2816
LN_EPS = 1e-5
ALPHA = (2.0 * DEPTH) ** 0.25
BETA = (8.0 * DEPTH) ** -0.25
MASK_VALUE = -1e30

OFF_B = 0
OFF_C = OFF_B + D_CONV
OFF_H = OFF_C + D_CONV
OFF_Q = OFF_H + D_CONV
OFF_K = OFF_Q + ATT_QKV_W
OFF_V = OFF_K + ATT_QKV_W
OFF_GA = OFF_V + ATT_QKV_W
OFF_GB = OFF_GA + D_MODEL
N_IN = OFF_GB + D_MODEL

kernel_name = "hybrid_shortconv_dilated_alibi_deepnorm_encoder"


def layer_norm(x, g, b):
    xf = x.astype(jnp.float32)
    mu = jnp.mean(xf, -1, keepdims=True)
    xc = xf - mu
    var = jnp.mean(xc * xc, -1, keepdims=True)
    return (xc * lax.rsqrt(var + LN_EPS) * g + b).astype(x.dtype)


def dwconv3(u, w):
    up = jnp.pad(u, ((0, 0), (1, 1), (0, 0)))
    return up[:, :-2] * w[0] + up[:, 1:-1] * w[1] + up[:, 2:] * w[2]


def alibi_slopes(n):
    return jnp.exp2(-8.0 * jnp.arange(1, n + 1, dtype=jnp.float32) / n)


def dilated_window_attention(q, k, v, dil, radius, slopes):
    bsz, seq, nh, hd = q.shape
    sub_len = seq // dil
    blk = radius
    nb = -(-sub_len // blk)
    lp = nb * blk

    def to_sub(a):
        a = a.reshape(bsz, sub_len, dil, nh, hd).transpose(0, 2, 1, 3, 4)
        return a.reshape(bsz * dil, sub_len, nh, hd)

    qs, ks, vs = to_sub(q), to_sub(k), to_sub(v)
    qb = jnp.pad(qs, ((0, 0), (0, lp - sub_len), (0, 0), (0, 0))).reshape(bsz * dil, nb, blk, nh, hd)

    def windows(a):
        ap = jnp.pad(a, ((0, 0), (blk, lp - sub_len + blk), (0, 0), (0, 0)))
        ap = ap.reshape(bsz * dil, nb + 2, blk, nh, hd)
        return jnp.concatenate([ap[:, :-2], ap[:, 1:-1], ap[:, 2:]], axis=2)

    kw, vw = windows(ks), windows(vs)
    qpos = jnp.arange(lp).reshape(nb, blk)
    kpos = (jnp.arange(nb)[:, None] - 1) * blk + jnp.arange(3 * blk)[None, :]
    rel = kpos[:, None, :] - qpos[:, :, None]
    valid = (jnp.abs(rel) <= radius) & (kpos[:, None, :] >= 0) & (kpos[:, None, :] < sub_len)
    dist = (jnp.abs(rel) * dil).astype(jnp.float32)
    bias = -slopes[None, :, None, None] * dist[:, None]
    s = jnp.einsum('bnqhd,bnkhd->bnhqk', qb, kw).astype(jnp.float32) * (hd ** -0.5) + bias
    s = jnp.where(valid[:, None], s, MASK_VALUE)
    m = jnp.max(s, -1, keepdims=True)
    p = jnp.exp(s - m)
    den = jnp.sum(p, -1, keepdims=True)
    o = jnp.einsum('bnhqk,bnkhd->bnqhd', (p / den).astype(v.dtype), vw)
    lse = jnp.transpose((m + jnp.log(den))[..., 0], (0, 1, 3, 2))
    o = o.reshape(bsz, dil, lp, nh, hd)[:, :, :sub_len].transpose(0, 2, 1, 3, 4).reshape(bsz, seq, nh, hd)
    lse = lse.reshape(bsz, dil, lp, nh)[:, :, :sub_len].transpose(0, 2, 1, 3).reshape(bsz, seq, nh)
    return o, lse


def setup_inputs(seed: int = 0) -> dict:
    key = jax.random.key(seed)
    ks = jax.random.split(key, 24)

    def nrm(k, shape, scale):
        return jax.random.normal(k, shape, jnp.float32) * scale

    col_scale = np.ones((N_IN,), np.float32)
    col_scale[OFF_H:OFF_H + D_CONV] = BETA
    col_scale[OFF_V:OFF_V + ATT_QKV_W] = BETA
    L = DEPTH
    return {
        "x": nrm(ks[0], (BATCH, SEQ, D_MODEL), 1.0),
        "ln0_g": 1.0 + nrm(ks[1], (D_MODEL,), 0.02),
        "ln0_b": nrm(ks[2], (D_MODEL,), 0.02),
        "w_in": nrm(ks[3], (L, D_MODEL, N_IN), D_MODEL ** -0.5) * jnp.asarray(col_scale),
        "b_in": nrm(ks[4], (L, N_IN), 0.02),
        "conv_w": nrm(ks[5], (L, CONV_WIDTH, D_CONV), CONV_WIDTH ** -0.5),
        "w_a": nrm(ks[6], (L, D_CONV, D_MODEL), BETA * D_CONV ** -0.5),
        "w_b": nrm(ks[7], (L, ATT_GROUP_W, D_MODEL), BETA * ATT_GROUP_W ** -0.5),
        "w_o": nrm(ks[8], (L, D_MODEL, D_MODEL), BETA * D_MODEL ** -0.5),
        "b_o": nrm(ks[9], (L, D_MODEL), 0.02),
        "ln1_g": 1.0 + nrm(ks[10], (L, D_MODEL), 0.02),
        "ln1_b": nrm(ks[11], (L, D_MODEL), 0.02),
        "w_up": nrm(ks[12], (L, D_MODEL, 2 * D_FF), BETA * D_MODEL ** -0.5),
        "b_up": nrm(ks[13], (L, 2 * D_FF), 0.02),
        "ffn_conv_w": nrm(ks[14], (L, CONV_WIDTH, D_FF), CONV_WIDTH ** -0.5),
        "ffn_conv_b": nrm(ks[15], (L, D_FF), 0.02),
        "w_down": nrm(ks[16], (L, D_FF, D_MODEL), BETA * D_FF ** -0.5),
        "b_down": nrm(ks[17], (L, D_MODEL), 0.02),
        "ln2_g": 1.0 + nrm(ks[18], (L, D_MODEL), 0.02),
        "ln2_b": nrm(ks[19], (L, D_MODEL), 0.02),
    }


def reference(x, ln0_g, ln0_b, w_in, b_in, conv_w, w_a, w_b, w_o, b_o, ln1_g, ln1_b,
              w_up, b_up, ffn_conv_w, ffn_conv_b, w_down, b_down, ln2_g, ln2_b):
    bsz, seq, _ = x.shape
    slopes = alibi_slopes(N_ATT_HEADS).reshape(N_GROUPS, HEADS_PER_GROUP)
    h = layer_norm(x, ln0_g, ln0_b)
    for l in range(DEPTH):
        proj = h @ w_in[l] + b_in[l]
        gate_b = proj[..., OFF_B:OFF_B + D_CONV]
        gate_c = proj[..., OFF_C:OFF_C + D_CONV]
        hin = proj[..., OFF_H:OFF_H + D_CONV]
        y_a = (gate_b * dwconv3(gate_c * hin, conv_w[l])) @ w_a[l]
        q = proj[..., OFF_Q:OFF_Q + ATT_QKV_W].reshape(bsz, seq, N_GROUPS, HEADS_PER_GROUP, HEAD_DIM)
        k = proj[..., OFF_K:OFF_K + ATT_QKV_W].reshape(bsz, seq, N_GROUPS, HEADS_PER_GROUP, HEAD_DIM)
        v = proj[..., OFF_V:OFF_V + ATT_QKV_W].reshape(bsz, seq, N_GROUPS, HEADS_PER_GROUP, HEAD_DIM)
        outs, lses = [], []
        for g, (window, dil) in enumerate(GROUPS):
            o, lse = dilated_window_attention(q[:, :, g], k[:, :, g], v[:, :, g], dil,
                                              window // (2 * dil), slopes[g])
            outs.append(o)
            lses.append(lse)
        wts = jax.nn.softmax(jnp.stack(lses, 0), axis=0)
        comb = jnp.sum(wts[..., None].astype(x.dtype) * jnp.stack(outs, 0), axis=0)
        y_b = comb.reshape(bsz, seq, ATT_GROUP_W) @ w_b[l]
        g_a = jax.nn.sigmoid(proj[..., OFF_GA:OFF_GA + D_MODEL])
        g_b = jax.nn.sigmoid(proj[..., OFF_GB:OFF_GB + D_MODEL])
        mix = (g_a * y_a + g_b * y_b) @ w_o[l] + b_o[l]
        h = layer_norm(ALPHA * h + mix, ln1_g[l], ln1_b[l])
        up = h @ w_up[l] + b_up[l]
        a, gte = up[..., :D_FF], up[..., D_FF:]
        f = jax.nn.gelu(dwconv3(a, ffn_conv_w[l]) + ffn_conv_b[l], approximate=False) * gte
        ffn = f @ w_down[l] + b_down[l]
        h = layer_norm(ALPHA * h + ffn, ln2_g[l], ln2_b[l])
    return h
```

```cpp
#include <hip/hip_runtime.h>
#include <cstdio>
#include <cstdint>

typedef unsigned short bf16;
typedef unsigned v4u __attribute__((ext_vector_type(4)));
typedef float f32x4 __attribute__((ext_vector_type(4)));

constexpr int BATCH = 2, SEQ = 8192, D = 1024, M = BATCH * SEQ;
constexpr int DQKV = 1536, DFF = 2816, NIN = 9728, NP1 = 7680, NG = 2048, NUP = 2 * DFF;
constexpr int OFF_B = 0, OFF_C = 1024, OFF_H = 2048, OFF_Q = 3072, OFF_K = 4608, OFF_V = 6144, OFF_GA = 7680, OFF_GB = 8704;
constexpr float LN_EPS = 1e-5f;
constexpr float ALPHA = 1.189207115002721f;
constexpr float LOG2E = 1.4426950408889634f;
constexpr float QSCALE = 0.125f * LOG2E;

constexpr size_t MiB = 1u << 20;
constexpr size_t WS_CTL = 0;
constexpr size_t WS_ST0 = 512 * 1024;
constexpr size_t WS_BIASP = 640 * 1024;
constexpr size_t WS_BUPP = 704 * 1024;
constexpr size_t WS_LSE = 768 * 1024;
constexpr size_t WS_WUP = 1 * MiB;
constexpr size_t WS_WDN = 12 * MiB;
constexpr size_t WS_WIN = 18 * MiB;
constexpr size_t WS_WAB = 37 * MiB;
constexpr size_t WS_WO = 40 * MiB;
constexpr size_t WS_XN = 42 * MiB;
constexpr size_t WS_ZC = 74 * MiB;
constexpr size_t WS_U = 122 * MiB;
constexpr size_t WS_Q = 154 * MiB;
constexpr size_t WS_K = 202 * MiB;
constexpr size_t WS_G = 122 * MiB;
constexpr size_t WS_MG = 202 * MiB;
constexpr size_t WS_A1 = 74 * MiB;
constexpr size_t WS_GT = 162 * MiB;
constexpr size_t WS_END = 250 * MiB;

__device__ __forceinline__ float bf2f(bf16 v) { return __uint_as_float((unsigned)v << 16); }
__device__ __forceinline__ unsigned f2bf(float f) { unsigned u = __float_as_uint(f); return (u + 0x7fffu + ((u >> 16) & 1u)) >> 16; }
__device__ __forceinline__ unsigned pk2(float lo, float hi) { return f2bf(lo) | (f2bf(hi) << 16); }

__host__ __device__ __forceinline__ int win_row(int n) {
    if (n >= OFF_C && n < OFF_H) { const int c = n - OFF_C; return 1024 + 256 * (c >> 7) + (c & 127); }
    if (n >= OFF_H && n < OFF_Q) { const int c = n - OFF_H; return 1024 + 256 * (c >> 7) + 128 + (c & 127); }
    return n;
}
__host__ __device__ __forceinline__ int wup_row(int n) {
    if (n < DFF) return 256 * (n >> 7) + (n & 127);
    const int c = n - DFF; return 256 * (c >> 7) + 128 + (c & 127);
}

__global__ void k_transpose(const float* __restrict__ W, int K, int N, bf16* __restrict__ WT, int ldk, int koff, int mode) {
    __shared__ float t[32][33];
    const int n0 = blockIdx.x * 32, k0 = blockIdx.y * 32, tx = threadIdx.x & 31, ty = threadIdx.x >> 5;
    for (int i = ty; i < 32; i += 8) t[i][tx] = W[(size_t)(k0 + i) * N + n0 + tx];
    __syncthreads();
    for (int i = ty; i < 32; i += 8) { const int n = n0 + i; const int r = mode == 1 ? win_row(n) : mode == 2 ? wup_row(n) : n;
        WT[(size_t)r * ldk + koff + k0 + tx] = (bf16)f2bf(t[tx][i]); }
}
__global__ void k_bias_perm(const float* __restrict__ b_in, const float* __restrict__ b_up, float* __restrict__ biasp, float* __restrict__ bupp) {
    const int i = blockIdx.x * blockDim.x + threadIdx.x;
    if (i < NIN) biasp[win_row(i)] = b_in[i];
    if (i < NUP) bupp[wup_row(i)] = b_up[i];
}
__device__ __forceinline__ float wave_sum(float v) {
#pragma unroll
    for (int o = 1; o < 64; o <<= 1) v += __shfl_xor(v, o);
    return v;
}
__global__ void k_ln(const float* x, const float* __restrict__ g, const float* __restrict__ b, float* of32, bf16* obf, float* st) {
    const int row = blockIdx.x * 4 + (threadIdx.x >> 6), lane = threadIdx.x & 63;
    const f32x4* xr = (const f32x4*)(x + (size_t)row * D) + lane;
    f32x4 v[4]; float s = 0.f;
#pragma unroll
    for (int j = 0; j < 4; ++j) { v[j] = xr[64 * j]; s += (v[j].x + v[j].y) + (v[j].z + v[j].w); }
    const float mean = wave_sum(s) * (1.f / D); float s2 = 0.f;
#pragma unroll
    for (int j = 0; j < 4; ++j) { v[j] = v[j] - mean; s2 += (v[j].x * v[j].x + v[j].y * v[j].y) + (v[j].z * v[j].z + v[j].w * v[j].w); }
    const float rstd = 1.f / sqrtf(wave_sum(s2) * (1.f / D) + LN_EPS);
    if (st && lane == 0) { st[2 * row] = mean; st[2 * row + 1] = rstd; }
#pragma unroll
    for (int j = 0; j < 4; ++j) {
        const f32x4 gg = ((const f32x4*)g)[lane + 64 * j], bb = ((const f32x4*)b)[lane + 64 * j];
        const f32x4 y = v[j] * rstd * gg + bb;
        if (of32) ((f32x4*)(of32 + (size_t)row * D))[lane + 64 * j] = y;
        if (obf) ((unsigned long long*)(obf + (size_t)row * D))[lane + 64 * j] = (unsigned long long)pk2(y.x, y.y) | ((unsigned long long)pk2(y.z, y.w) << 32);
    }
}

template <int K>
__device__ __forceinline__ void nv_dot8(const bf16* __restrict__ A, int lda, const bf16* __restrict__ Brow, float (&acc)[8]) {
#pragma unroll
    for (int r = 0; r < 8; ++r) acc[r] = 0.f;
    for (int k = 0; k < K; k += 8) {
        const v4u bv = *(const v4u*)(Brow + k);
        float bfv[8];
#pragma unroll
        for (int j = 0; j < 4; ++j) { bfv[2 * j] = __uint_as_float(bv[j] << 16); bfv[2 * j + 1] = __uint_as_float(bv[j] & 0xffff0000u); }
#pragma unroll
        for (int r = 0; r < 8; ++r) {
            const v4u av = *(const v4u*)(A + (size_t)r * lda + k);
#pragma unroll
            for (int j = 0; j < 4; ++j) { acc[r] += __uint_as_float(av[j] << 16) * bfv[2 * j]; acc[r] += __uint_as_float(av[j] & 0xffff0000u) * bfv[2 * j + 1]; }
        }
    }
}
__device__ __forceinline__ float sigmoidf_(float v) { return 1.f / (1.f + __expf(-v)); }

__global__ void nv_proj(const bf16* __restrict__ XN, const bf16* __restrict__ WinT, const float* __restrict__ biasp,
                        bf16* ZC, bf16* U, bf16* Q, bf16* Kb, bf16* Vb, bf16* G, int n_off) {
    const int n = n_off + blockIdx.x * 256 + threadIdx.x, row0 = blockIdx.y * 8;
    float acc[8]; nv_dot8<D>(XN + (size_t)row0 * D, D, WinT + (size_t)n * D, acc);
    const float bs = biasp[n];
    if (n >= 1024 && n < 3072) {
        __shared__ float sh[8][256];
#pragma unroll
        for (int r = 0; r < 8; ++r) sh[r][threadIdx.x] = acc[r] + bs;
        __syncthreads();
        if (threadIdx.x < 128) { const int ch = 128 * ((n - 1024) >> 8) + threadIdx.x;
#pragma unroll
            for (int r = 0; r < 8; ++r) U[(size_t)(row0 + r) * D + ch] = (bf16)f2bf(sh[r][threadIdx.x] * sh[r][threadIdx.x + 128]); }
        return;
    }
#pragma unroll
    for (int r = 0; r < 8; ++r) {
        const float v = acc[r] + bs; const size_t row = row0 + r;
        if (n < 1024) ZC[row * 1536 + n] = (bf16)f2bf(v);
        else if (n < 4608) Q[row * DQKV + (n - 3072)] = (bf16)f2bf(v * QSCALE);
        else if (n < 6144) Kb[row * DQKV + (n - 4608)] = (bf16)f2bf(v);
        else if (n < 7680) Vb[row * DQKV + (n - 6144)] = (bf16)f2bf(v);
        else G[row * NG + (n - 7680)] = (bf16)f2bf(sigmoidf_(v));
    }
}
__global__ void nv_za(bf16* ZC, const bf16* __restrict__ U, const float* __restrict__ cw) {
    const int ch = blockIdx.x * 256 + threadIdx.x, t = blockIdx.y, tt = t & (SEQ - 1);
    const float um = tt > 0 ? bf2f(U[(size_t)(t - 1) * D + ch]) : 0.f, u0 = bf2f(U[(size_t)t * D + ch]), up = tt < SEQ - 1 ? bf2f(U[(size_t)(t + 1) * D + ch]) : 0.f;
    const float cv = cw[ch] * um + cw[D + ch] * u0 + cw[2 * D + ch] * up;
    ZC[(size_t)t * 1536 + ch] = (bf16)f2bf(bf2f(ZC[(size_t)t * 1536 + ch]) * cv);
}
__global__ void nv_attn(const bf16* __restrict__ Q, const bf16* __restrict__ Kb, const bf16* __restrict__ Vb, bf16* ZC) {
    const int wv = blockIdx.x * 4 + (threadIdx.x >> 6), lane = threadIdx.x & 63;
    const int t = wv >> 3, hs = wv & 7, bb = t / SEQ, tt = t - bb * SEQ;
    float m = -1e30f, l = 0.f, o = 0.f;
    for (int g = 0; g < 3; ++g) {
        const int dil = g == 0 ? 1 : g == 1 ? 4 : 16;
        const int col = g * 512 + hs * 64 + lane;
        const float slope2 = exp2f(-8.0f * (float)(g * 8 + hs + 1) / 24.0f) * LOG2E * (float)dil;
        const float q = bf2f(Q[(size_t)t * DQKV + col]);
        for (int j = -64; j <= 64; ++j) {
            const int ss = tt + j * dil;
            if (ss < 0 || ss >= SEQ) continue;
            const size_t kr = (size_t)(bb * SEQ + ss) * DQKV + col;
            const float s = wave_sum(q * bf2f(Kb[kr])) - slope2 * (float)(j < 0 ? -j : j);
            const float mn = fmaxf(m, s), a = exp2f(m - mn), p = exp2f(s - mn);
            l = l * a + p; o = o * a + p * bf2f(Vb[kr]); m = mn;
        }
    }
    ZC[(size_t)t * 1536 + 1024 + hs * 64 + lane] = (bf16)f2bf(o / l);
}
__global__ void nv_merge(const bf16* __restrict__ ZC, const bf16* __restrict__ WabT, const bf16* __restrict__ G, bf16* MG) {
    const int n = blockIdx.x * 256 + threadIdx.x, row0 = blockIdx.y * 8;
    float a1[8], a2[8];
    nv_dot8<1024>(ZC + (size_t)row0 * 1536, 1536, WabT + (size_t)n * 1536, a1);
    nv_dot8<512>(ZC + (size_t)row0 * 1536 + 1024, 1536, WabT + (size_t)n * 1536 + 1024, a2);
#pragma unroll
    for (int r = 0; r < 8; ++r) { const size_t row = row0 + r;
        MG[row * D + n] = (bf16)f2bf(bf2f(G[row * NG + n]) * a1[r] + bf2f(G[row * NG + 1024 + n]) * a2[r]); }
}
__global__ void nv_mix(const bf16* __restrict__ MG, const bf16* __restrict__ WoT, const float* __restrict__ bo, const float* __restrict__ x, const float* __restrict__ st,
                       const float* __restrict__ g0, const float* __restrict__ b0, float* R1) {
    const int n = blockIdx.x * 256 + threadIdx.x, row0 = blockIdx.y * 8;
    float acc[8]; nv_dot8<D>(MG + (size_t)row0 * D, D, WoT + (size_t)n * D, acc);
#pragma unroll
    for (int r = 0; r < 8; ++r) { const size_t row = row0 + r;
        const float h = (x[row * D + n] - st[2 * row]) * st[2 * row + 1] * g0[n] + b0[n];
        R1[row * D + n] = ALPHA * h + acc[r] + bo[n]; }
}
__global__ void nv_up(const bf16* __restrict__ XN1, const bf16* __restrict__ WupT, const float* __restrict__ bupp, bf16* A1, bf16* GT) {
    const int n = blockIdx.x * 256 + threadIdx.x, row0 = blockIdx.y * 8;
    float acc[8]; nv_dot8<D>(XN1 + (size_t)row0 * D, D, WupT + (size_t)n * D, acc);
    const float bs = bupp[n]; const int j = n >> 8, w = n & 255;
#pragma unroll
    for (int r = 0; r < 8; ++r) { const size_t row = row0 + r;
        if (w < 128) A1[row * DFF + 128 * j + w] = (bf16)f2bf(acc[r] + bs); else GT[row * DFF + 128 * j + w - 128] = (bf16)f2bf(acc[r] + bs); }
}
__global__ void nv_f(const bf16* __restrict__ A1, bf16* GT, const float* __restrict__ cw, const float* __restrict__ cb) {
    const int ch = blockIdx.x * 256 + threadIdx.x, t = blockIdx.y, tt = t & (SEQ - 1);
    const float am = tt > 0 ? bf2f(A1[(size_t)(t - 1) * DFF + ch]) : 0.f, a0 = bf2f(A1[(size_t)t * DFF + ch]), ap = tt < SEQ - 1 ? bf2f(A1[(size_t)(t + 1) * DFF + ch]) : 0.f;
    const float v = cw[ch] * am + cw[DFF + ch] * a0 + cw[2 * DFF + ch] * ap + cb[ch];
    const float ge = 0.5f * v * (1.f + erff(v * 0.70710678118654752f));
    GT[(size_t)t * DFF + ch] = (bf16)f2bf(ge * bf2f(GT[(size_t)t * DFF + ch]));
}
__global__ void nv_down(const bf16* __restrict__ F, const bf16* __restrict__ WdT, const float* __restrict__ bd, float* H1) {
    const int n = blockIdx.x * 256 + threadIdx.x, row0 = blockIdx.y * 8;
    float acc[8]; nv_dot8<DFF>(F + (size_t)row0 * DFF, DFF, WdT + (size_t)n * DFF, acc);
#pragma unroll
    for (int r = 0; r < 8; ++r) { const size_t row = row0 + r; H1[row * D + n] = ALPHA * H1[row * D + n] + acc[r] + bd[n]; }
}

extern "C" void kernel_launch(void* const* d_in, const int* in_sizes, int n_in, void* d_out, int out_size, void* d_ws, size_t ws_size, hipStream_t stream) {
    if (n_in != 20 || out_size != M * D || ws_size < WS_END) { fprintf(stderr, "kernel_launch: unexpected shapes (n_in %d out %d ws %zu)\n", n_in, out_size, ws_size); return; }
    const float* x = (const float*)d_in[0]; const float* ln0_g = (const float*)d_in[1]; const float* ln0_b = (const float*)d_in[2];
    const float* w_in = (const float*)d_in[3]; const float* b_in = (const float*)d_in[4]; const float* conv_w = (const float*)d_in[5];
    const float* w_a = (const float*)d_in[6]; const float* w_b = (const float*)d_in[7]; const float* w_o = (const float*)d_in[8]; const float* b_o = (const float*)d_in[9];
    const float* ln1_g = (const float*)d_in[10]; const float* ln1_b = (const float*)d_in[11]; const float* w_up = (const float*)d_in[12]; const float* b_up = (const float*)d_in[13];
    const float* fcw = (const float*)d_in[14]; const float* fcb = (const float*)d_in[15]; const float* w_dn = (const float*)d_in[16]; const float* b_dn = (const float*)d_in[17];
    const float* ln2_g = (const float*)d_in[18]; const float* ln2_b = (const float*)d_in[19];
    unsigned char* ws = (unsigned char*)d_ws; float* out = (float*)d_out;
    float* ST0 = (float*)(ws + WS_ST0); float* BIASP = (float*)(ws + WS_BIASP); float* BUPP = (float*)(ws + WS_BUPP);
    bf16 *WUP = (bf16*)(ws + WS_WUP), *WDN = (bf16*)(ws + WS_WDN), *WIN = (bf16*)(ws + WS_WIN), *WAB = (bf16*)(ws + WS_WAB), *WO = (bf16*)(ws + WS_WO);
    bf16 *XN = (bf16*)(ws + WS_XN), *ZC = (bf16*)(ws + WS_ZC), *U = (bf16*)(ws + WS_U), *Q = (bf16*)(ws + WS_Q), *Kb = (bf16*)(ws + WS_K), *Vb = (bf16*)d_out;
    bf16 *G = (bf16*)(ws + WS_G), *MG = (bf16*)(ws + WS_MG), *A1 = (bf16*)(ws + WS_A1), *GT = (bf16*)(ws + WS_GT);
    k_transpose<<<dim3(NIN / 32, D / 32), 256, 0, stream>>>(w_in, D, NIN, WIN, D, 0, 1);
    k_transpose<<<dim3(D / 32, D / 32), 256, 0, stream>>>(w_a, D, D, WAB, 1536, 0, 0);
    k_transpose<<<dim3(D / 32, 512 / 32), 256, 0, stream>>>(w_b, 512, D, WAB, 1536, 1024, 0);
    k_transpose<<<dim3(D / 32, D / 32), 256, 0, stream>>>(w_o, D, D, WO, D, 0, 0);
    k_transpose<<<dim3(NUP / 32, D / 32), 256, 0, stream>>>(w_up, D, NUP, WUP, D, 0, 2);
    k_transpose<<<dim3(D / 32, DFF / 32), 256, 0, stream>>>(w_dn, DFF, D, WDN, DFF, 0, 0);
    k_bias_perm<<<(NIN + 255) / 256, 256, 0, stream>>>(b_in, b_up, BIASP, BUPP);
    k_ln<<<M / 4, 256, 0, stream>>>(x, ln0_g, ln0_b, nullptr, XN, ST0);
    nv_proj<<<dim3(NP1 / 256, M / 8), 256, 0, stream>>>(XN, WIN, BIASP, ZC, U, Q, Kb, Vb, G, 0);
    nv_attn<<<M * 8 / 4, 256, 0, stream>>>(Q, Kb, Vb, ZC);
    nv_za<<<dim3(D / 256, M), 256, 0, stream>>>(ZC, U, conv_w);
    nv_proj<<<dim3(NG / 256, M / 8), 256, 0, stream>>>(XN, WIN, BIASP, ZC, U, Q, Kb, Vb, G, NP1);
    nv_merge<<<dim3(4, M / 8), 256, 0, stream>>>(ZC, WAB, G, MG);
    nv_mix<<<dim3(4, M / 8), 256, 0, stream>>>(MG, WO, b_o, x, ST0, ln0_g, ln0_b, out);
    k_ln<<<M / 4, 256, 0, stream>>>(out, ln1_g, ln1_b, out, XN, nullptr);
    nv_up<<<dim3(NUP / 256, M / 8), 256, 0, stream>>>(XN, WUP, BUPP, A1, GT);
    nv_f<<<dim3(DFF / 256, M), 256, 0, stream>>>(A1, GT, fcw, fcb);
    nv_down<<<dim3(4, M / 8), 256, 0, stream>>>(GT, WDN, b_dn, out);
    k_ln<<<M / 4, 256, 0, stream>>>(out, ln2_g, ln2_b, out, nullptr, nullptr);
}
```

```cpp
#include <hip/hip_runtime.h>
#include <cstdio>
#include <cstdint>

typedef unsigned short bf16;
typedef unsigned v4u __attribute__((ext_vector_type(4)));
typedef float f32x4 __attribute__((ext_vector_type(4)));

constexpr int BATCH = 2, SEQ = 8192, D = 1024, M = BATCH * SEQ;
constexpr int DQKV = 1536, DFF = 2816, NIN = 9728, NP1 = 7680, NG = 2048, NUP = 2 * DFF;
constexpr int OFF_B = 0, OFF_C = 1024, OFF_H = 2048, OFF_Q = 3072, OFF_K = 4608, OFF_V = 6144, OFF_GA = 7680, OFF_GB = 8704;
constexpr float LN_EPS = 1e-5f;
constexpr float ALPHA = 1.189207115002721f;
constexpr float LOG2E = 1.4426950408889634f;
constexpr float QSCALE = 0.125f * LOG2E;

constexpr size_t MiB = 1u << 20;
constexpr size_t WS_CTL = 0;
constexpr size_t WS_ST0 = 512 * 1024;
constexpr size_t WS_BIASP = 640 * 1024;
constexpr size_t WS_BUPP = 704 * 1024;
constexpr size_t WS_WUP = 1 * MiB;
constexpr size_t WS_WDN = 12 * MiB;
constexpr size_t WS_WIN = 18 * MiB;
constexpr size_t WS_WAB = 37 * MiB;
constexpr size_t WS_WO = 40 * MiB;
constexpr size_t WS_XN = 42 * MiB;
constexpr size_t WS_ZC = 74 * MiB;
constexpr size_t WS_U = 122 * MiB;
constexpr size_t WS_Q = 154 * MiB;
constexpr size_t WS_K = 202 * MiB;
constexpr size_t WS_G = 122 * MiB;
constexpr size_t WS_MG = 202 * MiB;
constexpr size_t WS_A1 = 74 * MiB;
constexpr size_t WS_GT = 162 * MiB;
constexpr size_t WS_LSE = 250 * MiB;
constexpr size_t WS_END = 252 * MiB;

__device__ __forceinline__ float bf2f(bf16 v) { return __uint_as_float((unsigned)v << 16); }
__device__ __forceinline__ unsigned f2bf(float f) { unsigned u = __float_as_uint(f); return (u + 0x7fffu + ((u >> 16) & 1u)) >> 16; }
__device__ __forceinline__ unsigned pk2(float lo, float hi) { return f2bf(lo) | (f2bf(hi) << 16); }

__host__ __device__ __forceinline__ int win_row(int n) {
    if (n >= OFF_C && n < OFF_H) { const int c = n - OFF_C; return 1024 + 256 * (c >> 7) + (c & 127); }
    if (n >= OFF_H && n < OFF_Q) { const int c = n - OFF_H; return 1024 + 256 * (c >> 7) + 128 + (c & 127); }
    return n;
}
__host__ __device__ __forceinline__ int wup_row(int n) {
    if (n < DFF) return 256 * (n >> 7) + (n & 127);
    const int c = n - DFF; return 256 * (c >> 7) + 128 + (c & 127);
}

#define GAS __attribute__((address_space(1)))
#define LAS __attribute__((address_space(3)))
typedef GAS unsigned gu32;
#define RLX_AGENT __ATOMIC_RELAXED, __HIP_MEMORY_SCOPE_AGENT
#define LDS_WAIT() asm volatile("s_waitcnt lgkmcnt(0)" ::: "memory")
#define VM_WAIT() asm volatile("s_waitcnt vmcnt(0)" ::: "memory")

constexpr int NWAVES = 8, NTHREADS = NWAVES * 64;
constexpr size_t CTL_ZERO_BYTES = 256 * 1024;
constexpr int CW_BAR = 4096;
constexpr int RING_OFF = 0, RING_BYTES = 131072;
constexpr int LDSCTL_OFF = RING_BYTES, MISC_OFF = LDSCTL_OFF + 320;
constexpr int LDS_BYTES = 147456;

#define XB_TMO      128
#define XB_XCNT(j)  (256  + 64 * (j))
#define XB_XSUB(j)  (1280 + 64 * (j))
#define XB_XGEN(j)  (2304 + 64 * (j))
#define XB_TOP      3328
#define XB_TOPGEN   3392
#define XCD_BAR_WORDS 3456
#define XB_SPIN_CAP (1u << 18)
__device__ __forceinline__ unsigned xb_ld(unsigned* p)              { return __hip_atomic_load(p, __ATOMIC_RELAXED, __HIP_MEMORY_SCOPE_AGENT); }
__device__ __forceinline__ unsigned xb_add(unsigned* p, unsigned v) { return __hip_atomic_fetch_add(p, v, __ATOMIC_RELAXED, __HIP_MEMORY_SCOPE_AGENT); }
__device__ __forceinline__ unsigned xb_xcc_id() { return (unsigned)__builtin_amdgcn_s_getreg((3 << 11) | 20) & 0xFu; }
#define XB_SPIN(cond, bar) do { unsigned _sp = 0; while (cond) { __builtin_amdgcn_s_sleep(1); \
    if ((++_sp & 255u) == 0u) { if (xb_ld(&(bar)[XB_TMO])) break; if (_sp > XB_SPIN_CAP) { atomicAdd(&(bar)[XB_TMO], 1u); break; } } } } while (0)
struct XcdBarrier { unsigned* bar; unsigned x; volatile LAS unsigned* st; };
__device__ __forceinline__ XcdBarrier xcd_barrier_post(unsigned* bar, volatile LAS unsigned* st) {
    XcdBarrier b; b.bar = bar; b.x = xb_xcc_id(); b.st = st;
    if (threadIdx.x == 0) (void)xb_add(&bar[XB_XCNT(b.x)], 1u);
    return b;
}
__device__ __forceinline__ void xcd_barrier_complete(unsigned* bar, unsigned x, unsigned& nloc, unsigned& nx) {
    const unsigned G = gridDim.x * gridDim.y * gridDim.z;
    unsigned sum, cnt, mine, sp = 0u;
    for (;;) {
        sum = 0u; cnt = 0u; mine = 0u;
#pragma unroll
        for (unsigned j = 0; j < 16; ++j) { const unsigned c = xb_ld(&bar[XB_XCNT(j)]); sum += c; cnt += (c > 0u) ? 1u : 0u; mine = (j == x) ? c : mine; }
        if (sum == G) break;
        __builtin_amdgcn_s_sleep(1);
        if ((++sp & 255u) == 0u) { if (xb_ld(&bar[XB_TMO])) break; if (sp > XB_SPIN_CAP) { atomicAdd(&bar[XB_TMO], 1u); break; } }
    }
    nloc = mine > 0u ? mine : 1u; nx = cnt > 0u ? cnt : 1u;
}
__device__ __forceinline__ void xcd_barrier(const XcdBarrier& b) {
    asm volatile("s_waitcnt vmcnt(0)" ::: "memory");
    __syncthreads();
    if (threadIdx.x == 0) {
        unsigned* bar = b.bar;
        __builtin_amdgcn_s_waitcnt(0);
        unsigned nloc = b.st[0], nx = b.st[1];
        if (nloc == 0u) { xcd_barrier_complete(bar, b.x, nloc, nx); b.st[0] = nloc; b.st[1] = nx; }
        const unsigned old = xb_add(&bar[XB_XSUB(b.x)], 1u);
        const unsigned gen = old / nloc;
        if (old + 1u == (gen + 1u) * nloc) {
            __builtin_amdgcn_fence(__ATOMIC_RELEASE, "agent");
            asm volatile("s_waitcnt vmcnt(0)" ::: "memory");
            const unsigned og = xb_add(&bar[XB_TOP], 1u);
            const unsigned tg = og / nx;
            if (og + 1u == (tg + 1u) * nx) xb_add(&bar[XB_TOPGEN], 1u);
            else XB_SPIN(xb_ld(&bar[XB_TOPGEN]) == tg, bar);
            __builtin_amdgcn_fence(__ATOMIC_ACQUIRE, "agent");
            xb_add(&bar[XB_XGEN(b.x)], 1u);
            asm volatile("s_waitcnt vmcnt(0)" ::: "memory");
        } else {
            XB_SPIN(xb_ld(&bar[XB_XGEN(b.x)]) == gen, bar);
            __builtin_amdgcn_fence(__ATOMIC_ACQUIRE, "agent");
            asm volatile("s_waitcnt vmcnt(0)" ::: "memory");
        }
    }
    __syncthreads();
}

struct Frame {
    LAS unsigned char* lds; volatile LAS unsigned* MISC; gu32* ctl;
    int tid, lane, wave, vcu, G;
    const float *x, *ln0_g, *ln0_b, *w_in, *b_in, *conv_w, *w_a, *w_b, *w_o, *b_o, *ln1_g, *ln1_b, *w_up, *b_up, *fcw, *fcb, *w_dn, *b_dn, *ln2_g, *ln2_b;
    float* out; float *ST0, *BIASP, *BUPP, *LSE;
    bf16 *WUP, *WDN, *WIN, *WAB, *WO, *XN, *ZC, *U, *Q, *KB, *VB, *G_, *MG, *A1, *GT;
};
__device__ __forceinline__ float wave_sum(float v) {
#pragma unroll
    for (int o = 1; o < 64; o <<= 1) v += __shfl_xor(v, o);
    return v;
}
__device__ __forceinline__ void p0_transpose_item(const float* W, int K, int N, bf16* WT, int ldk, int koff, int mode, LAS float* scr, int item, int lane) {
    const int nblk = N / 32, kb = item / nblk, nb = item % nblk, k0 = 64 * kb, n0 = 32 * nb;
    const int r0 = mode == 1 ? win_row(n0) : mode == 2 ? wup_row(n0) : n0;
#pragma unroll 8
    for (int i = 0; i < 32; ++i) { const int kk = 2 * i + (lane >> 5); scr[kk * 33 + (lane & 31)] = W[(size_t)(k0 + kk) * N + n0 + (lane & 31)]; }
    LDS_WAIT(); asm volatile("" ::: "memory");
    const int c = lane & 7;
#pragma unroll
    for (int j = 0; j < 4; ++j) { const int n = (lane >> 3) + 8 * j; const LAS float* s = scr + (8 * c) * 33 + n;
        v4u o; o.x = pk2(s[0 * 33], s[1 * 33]); o.y = pk2(s[2 * 33], s[3 * 33]); o.z = pk2(s[4 * 33], s[5 * 33]); o.w = pk2(s[6 * 33], s[7 * 33]);
        *(GAS v4u*)(WT + (size_t)(r0 + n) * ldk + koff + k0 + 8 * c) = o; }
    LDS_WAIT(); asm volatile("" ::: "memory");
}
__device__ __forceinline__ void ln_row(const float* xrow, const float* g, const float* b, float* of32, bf16* obf, float* st, int lane) {
    const GAS f32x4* xr = (const GAS f32x4*)xrow + lane;
    f32x4 v[4]; float s = 0.f;
#pragma unroll
    for (int j = 0; j < 4; ++j) { v[j] = xr[64 * j]; s += (v[j].x + v[j].y) + (v[j].z + v[j].w); }
    const float mean = wave_sum(s) * (1.f / D); float s2 = 0.f;
#pragma unroll
    for (int j = 0; j < 4; ++j) { v[j] = v[j] - mean; s2 += (v[j].x * v[j].x + v[j].y * v[j].y) + (v[j].z * v[j].z + v[j].w * v[j].w); }
    const float rstd = 1.f / sqrtf(wave_sum(s2) * (1.f / D) + LN_EPS);
    if (st && lane == 0) { st[0] = mean; st[1] = rstd; }
#pragma unroll
    for (int j = 0; j < 4; ++j) {
        const f32x4 gg = ((const GAS f32x4*)g)[lane + 64 * j], bb = ((const GAS f32x4*)b)[lane + 64 * j];
        const f32x4 y = v[j] * rstd * gg + bb;
        if (of32) ((GAS f32x4*)of32)[lane + 64 * j] = y;
        if (obf) ((GAS unsigned long long*)obf)[lane + 64 * j] = (unsigned long long)pk2(y.x, y.y) | ((unsigned long long)pk2(y.z, y.w) << 32);
    }
}
__device__ __forceinline__ void p0_prologue(Frame& F) {
    LAS float* scr = (LAS float*)(F.lds + RING_OFF + F.wave * 16384);
    const int gw = F.vcu * NWAVES + F.wave, NGW = F.G * NWAVES;
    constexpr int I_IN = (D / 64) * (NIN / 32), I_A = (D / 64) * (D / 32), I_B = (512 / 64) * (D / 32), I_O = I_A, I_UP = (D / 64) * (NUP / 32), I_DN = (DFF / 64) * (D / 32);
    constexpr int NITEMS = I_IN + I_A + I_B + I_O + I_UP + I_DN;
    for (int it = gw; it < NITEMS; it += NGW) {
        int r = it;
        if (r < I_IN) { p0_transpose_item(F.w_in, D, NIN, F.WIN, D, 0, 1, scr, r, F.lane); continue; } r -= I_IN;
        if (r < I_A) { p0_transpose_item(F.w_a, D, D, F.WAB, 1536, 0, 0, scr, r, F.lane); continue; } r -= I_A;
        if (r < I_B) { p0_transpose_item(F.w_b, 512, D, F.WAB, 1536, 1024, 0, scr, r, F.lane); continue; } r -= I_B;
        if (r < I_O) { p0_transpose_item(F.w_o, D, D, F.WO, D, 0, 0, scr, r, F.lane); continue; } r -= I_O;
        if (r < I_UP) { p0_transpose_item(F.w_up, D, NUP, F.WUP, D, 0, 2, scr, r, F.lane); continue; } r -= I_UP;
        p0_transpose_item(F.w_dn, DFF, D, F.WDN, DFF, 0, 0, scr, r, F.lane);
    }
    for (int i = F.vcu * NTHREADS + F.tid; i < NIN; i += F.G * NTHREADS) { F.BIASP[win_row(i)] = F.b_in[i]; if (i < NUP) F.BUPP[wup_row(i)] = F.b_up[i]; }
    for (int m = gw; m < M; m += NGW) ln_row(F.x + (size_t)m * D, F.ln0_g, F.ln0_b, nullptr, F.XN + (size_t)m * D, F.ST0 + 2 * m, F.lane);
}

template <int K>
__device__ __forceinline__ void nv_dot8(const bf16* __restrict__ A, int lda, const bf16* __restrict__ Brow, float (&acc)[8]) {
#pragma unroll
    for (int r = 0; r < 8; ++r) acc[r] = 0.f;
    for (int k = 0; k < K; k += 8) {
        const v4u bv = *(const v4u*)(Brow + k);
        float bfv[8];
#pragma unroll
        for (int j = 0; j < 4; ++j) { bfv[2 * j] = __uint_as_float(bv[j] << 16); bfv[2 * j + 1] = __uint_as_float(bv[j] & 0xffff0000u); }
#pragma unroll
        for (int r = 0; r < 8; ++r) {
            const v4u av = *(const v4u*)(A + (size_t)r * lda + k);
#pragma unroll
            for (int j = 0; j < 4; ++j) { acc[r] += __uint_as_float(av[j] << 16) * bfv[2 * j]; acc[r] += __uint_as_float(av[j] & 0xffff0000u) * bfv[2 * j + 1]; }
        }
    }
}
__device__ __forceinline__ float sigmoidf_(float v) { return 1.f / (1.f + __expf(-v)); }
#define NV_LOOP(nbx, nby) for (int vb_ = 2 * (int)blockIdx.x + (F.tid >> 8); vb_ < (nbx) * (nby); vb_ += 2 * F.G)
#define NV_BX(nbx) (vb_ % (nbx))
#define NV_BY(nbx) (vb_ / (nbx))
__device__ __forceinline__ void nv_proj(Frame& F, int n_off, int ncols) {
    const int t256 = F.tid & 255, nbx = ncols / 256;
    NV_LOOP(nbx, M / 8) {
        const int n = n_off + NV_BX(nbx) * 256 + t256, row0 = NV_BY(nbx) * 8;
        if (n >= 1024 && n < 3072) {
            if (t256 < 128) {
                float ac[8], ah[8]; nv_dot8<D>(F.XN + (size_t)row0 * D, D, F.WIN + (size_t)n * D, ac); nv_dot8<D>(F.XN + (size_t)row0 * D, D, F.WIN + (size_t)(n + 128) * D, ah);
                const float bc = F.BIASP[n], bh = F.BIASP[n + 128]; const int ch = 128 * ((n - 1024) >> 8) + t256;
#pragma unroll
                for (int r = 0; r < 8; ++r) F.U[(size_t)(row0 + r) * D + ch] = (bf16)f2bf((ac[r] + bc) * (ah[r] + bh));
            }
            continue;
        }
        float acc[8]; nv_dot8<D>(F.XN + (size_t)row0 * D, D, F.WIN + (size_t)n * D, acc);
        const float bs = F.BIASP[n];
#pragma unroll
        for (int r = 0; r < 8; ++r) {
            const float v = acc[r] + bs; const size_t row = row0 + r;
            if (n < 1024) F.ZC[row * 1536 + n] = (bf16)f2bf(v);
            else if (n < 4608) F.Q[row * DQKV + (n - 3072)] = (bf16)f2bf(v * QSCALE);
            else if (n < 6144) F.KB[row * DQKV + (n - 4608)] = (bf16)f2bf(v);
            else if (n < 7680) F.VB[row * DQKV + (n - 6144)] = (bf16)f2bf(v);
            else F.G_[row * NG + (n - 7680)] = (bf16)f2bf(sigmoidf_(v));
        }
    }
}
__device__ __forceinline__ void nv_za(Frame& F) {
    const int t256 = F.tid & 255;
    NV_LOOP(4, M) {
        const int ch = NV_BX(4) * 256 + t256, t = NV_BY(4), tt = t & (SEQ - 1);
        const float um = tt > 0 ? bf2f(F.U[(size_t)(t - 1) * D + ch]) : 0.f, u0 = bf2f(F.U[(size_t)t * D + ch]), up = tt < SEQ - 1 ? bf2f(F.U[(size_t)(t + 1) * D + ch]) : 0.f;
        const float cv = F.conv_w[ch] * um + F.conv_w[D + ch] * u0 + F.conv_w[2 * D + ch] * up;
        F.ZC[(size_t)t * 1536 + ch] = (bf16)f2bf(bf2f(F.ZC[(size_t)t * 1536 + ch]) * cv);
    }
}
__device__ __forceinline__ void nv_attn(Frame& F) {
    for (int wv = F.vcu * NWAVES + F.wave; wv < M * 8; wv += F.G * NWAVES) {
        const int lane = F.lane, t = wv >> 3, hs = wv & 7, bb = t / SEQ, tt = t - bb * SEQ;
        float m = -1e30f, l = 0.f, o = 0.f;
        for (int g = 0; g < 3; ++g) {
            const int dil = g == 0 ? 1 : g == 1 ? 4 : 16;
            const int col = g * 512 + hs * 64 + lane;
            const float slope2 = exp2f(-8.0f * (float)(g * 8 + hs + 1) / 24.0f) * LOG2E * (float)dil;
            const float q = bf2f(F.Q[(size_t)t * DQKV + col]);
            for (int j = -64; j <= 64; ++j) {
                const int ss = tt + j * dil;
                if (ss < 0 || ss >= SEQ) continue;
                const size_t kr = (size_t)(bb * SEQ + ss) * DQKV + col;
                const float s = wave_sum(q * bf2f(F.KB[kr])) - slope2 * (float)(j < 0 ? -j : j);
                const float mn = fmaxf(m, s), a = exp2f(m - mn), p = exp2f(s - mn);
                l = l * a + p; o = o * a + p * bf2f(F.VB[kr]); m = mn;
            }
        }
        F.ZC[(size_t)t * 1536 + 1024 + hs * 64 + lane] = (bf16)f2bf(o / l);
    }
}
__device__ __forceinline__ void nv_merge(Frame& F) {
    const int t256 = F.tid & 255;
    NV_LOOP(4, M / 8) {
        const int n = NV_BX(4) * 256 + t256, row0 = NV_BY(4) * 8;
        float a1[8], a2[8];
        nv_dot8<1024>(F.ZC + (size_t)row0 * 1536, 1536, F.WAB + (size_t)n * 1536, a1);
        nv_dot8<512>(F.ZC + (size_t)row0 * 1536 + 1024, 1536, F.WAB + (size_t)n * 1536 + 1024, a2);
#pragma unroll
        for (int r = 0; r < 8; ++r) { const size_t row = row0 + r;
            F.MG[row * D + n] = (bf16)f2bf(bf2f(F.G_[row * NG + n]) * a1[r] + bf2f(F.G_[row * NG + 1024 + n]) * a2[r]); }
    }
}
__device__ __forceinline__ void nv_mix(Frame& F) {
    const int t256 = F.tid & 255;
    NV_LOOP(4, M / 8) {
        const int n = NV_BX(4) * 256 + t256, row0 = NV_BY(4) * 8;
        float acc[8]; nv_dot8<D>(F.MG + (size_t)row0 * D, D, F.WO + (size_t)n * D, acc);
#pragma unroll
        for (int r = 0; r < 8; ++r) { const size_t row = row0 + r;
            const float h = (F.x[row * D + n] - F.ST0[2 * row]) * F.ST0[2 * row + 1] * F.ln0_g[n] + F.ln0_b[n];
            F.out[row * D + n] = ALPHA * h + acc[r] + F.b_o[n]; }
    }
}
__device__ __forceinline__ void nv_up(Frame& F) {
    const int t256 = F.tid & 255;
    NV_LOOP(NUP / 256, M / 8) {
        const int n = NV_BX(NUP / 256) * 256 + t256, row0 = NV_BY(NUP / 256) * 8;
        float acc[8]; nv_dot8<D>(F.XN + (size_t)row0 * D, D, F.WUP + (size_t)n * D, acc);
        const float bs = F.BUPP[n]; const int j = n >> 8, w = n & 255;
#pragma unroll
        for (int r = 0; r < 8; ++r) { const size_t row = row0 + r;
            if (w < 128) F.A1[row * DFF + 128 * j + w] = (bf16)f2bf(acc[r] + bs); else F.GT[row * DFF + 128 * j + w - 128] = (bf16)f2bf(acc[r] + bs); }
    }
}
__device__ __forceinline__ void nv_f(Frame& F) {
    const int t256 = F.tid & 255;
    NV_LOOP(DFF / 256, M) {
        const int ch = NV_BX(DFF / 256) * 256 + t256, t = NV_BY(DFF / 256), tt = t & (SEQ - 1);
        const float am = tt > 0 ? bf2f(F.A1[(size_t)(t - 1) * DFF + ch]) : 0.f, a0 = bf2f(F.A1[(size_t)t * DFF + ch]), ap = tt < SEQ - 1 ? bf2f(F.A1[(size_t)(t + 1) * DFF + ch]) : 0.f;
        const float v = F.fcw[ch] * am + F.fcw[DFF + ch] * a0 + F.fcw[2 * DFF + ch] * ap + F.fcb[ch];
        const float ge = 0.5f * v * (1.f + erff(v * 0.70710678118654752f));
        F.GT[(size_t)t * DFF + ch] = (bf16)f2bf(ge * bf2f(F.GT[(size_t)t * DFF + ch]));
    }
}
__device__ __forceinline__ void nv_down(Frame& F) {
    const int t256 = F.tid & 255;
    NV_LOOP(4, M / 8) {
        const int n = NV_BX(4) * 256 + t256, row0 = NV_BY(4) * 8;
        float acc[8]; nv_dot8<DFF>(F.GT + (size_t)row0 * DFF, DFF, F.WDN + (size_t)n * DFF, acc);
#pragma unroll
        for (int r = 0; r < 8; ++r) { const size_t row = row0 + r; F.out[row * D + n] = ALPHA * F.out[row * D + n] + acc[r] + F.b_dn[n]; }
    }
}
__device__ __forceinline__ void ln_phase(Frame& F, const float* g, const float* b, bf16* obf) {
    for (int m = F.vcu * NWAVES + F.wave; m < M; m += F.G * NWAVES) ln_row(F.out + (size_t)m * D, g, b, F.out + (size_t)m * D, obf ? obf + (size_t)m * D : nullptr, nullptr, F.lane);
}

struct Args { const float* in[20]; float* out; unsigned char* ws; int ph_lo, ph_hi; };
constexpr int NPHASE = 11;
__global__ void __launch_bounds__(NTHREADS, 2) mk_fwd(Args args) {
    extern __shared__ __attribute__((aligned(16))) unsigned char lds[];
    Frame F;
    F.lds = (LAS unsigned char*)lds; F.MISC = (volatile LAS unsigned*)(F.lds + MISC_OFF);
    F.tid = threadIdx.x; F.lane = F.tid & 63; F.wave = __builtin_amdgcn_readfirstlane(F.tid >> 6);
    F.G = gridDim.x; { const int bx = blockIdx.x; F.vcu = (F.G % 8 == 0) ? (bx % 8) * (F.G / 8) + bx / 8 : bx; }
    unsigned char* ws = args.ws;
    F.ctl = (gu32*)(ws + WS_CTL);
    F.x = args.in[0]; F.ln0_g = args.in[1]; F.ln0_b = args.in[2]; F.w_in = args.in[3]; F.b_in = args.in[4]; F.conv_w = args.in[5]; F.w_a = args.in[6]; F.w_b = args.in[7];
    F.w_o = args.in[8]; F.b_o = args.in[9]; F.ln1_g = args.in[10]; F.ln1_b = args.in[11]; F.w_up = args.in[12]; F.b_up = args.in[13]; F.fcw = args.in[14]; F.fcb = args.in[15];
    F.w_dn = args.in[16]; F.b_dn = args.in[17]; F.ln2_g = args.in[18]; F.ln2_b = args.in[19]; F.out = args.out;
    F.ST0 = (float*)(ws + WS_ST0); F.BIASP = (float*)(ws + WS_BIASP); F.BUPP = (float*)(ws + WS_BUPP); F.LSE = (float*)(ws + WS_LSE);
    F.WUP = (bf16*)(ws + WS_WUP); F.WDN = (bf16*)(ws + WS_WDN); F.WIN = (bf16*)(ws + WS_WIN); F.WAB = (bf16*)(ws + WS_WAB); F.WO = (bf16*)(ws + WS_WO);
    F.XN = (bf16*)(ws + WS_XN); F.ZC = (bf16*)(ws + WS_ZC); F.U = (bf16*)(ws + WS_U); F.Q = (bf16*)(ws + WS_Q); F.KB = (bf16*)(ws + WS_K); F.VB = (bf16*)args.out;
    F.G_ = (bf16*)(ws + WS_G); F.MG = (bf16*)(ws + WS_MG); F.A1 = (bf16*)(ws + WS_A1); F.GT = (bf16*)(ws + WS_GT);
    for (int u = F.tid; u < (LDS_BYTES - LDSCTL_OFF) / 4; u += NTHREADS) ((LAS unsigned*)(F.lds + LDSCTL_OFF))[u] = 0u;
    __syncthreads();
    XcdBarrier bar = xcd_barrier_post((unsigned*)(F.ctl + CW_BAR), F.MISC + 8);
    const int lo = args.ph_lo, hi = args.ph_hi;
#define IN(k) (lo <= (k) && (k) < hi)
#define SEAM(k) do { if (IN(k) && IN((k) + 1)) xcd_barrier(bar); } while (0)
    if (IN(0)) { p0_prologue(F); } SEAM(0);
    if (IN(1)) { nv_proj(F, 0, NP1); } SEAM(1);
    if (IN(2)) { nv_attn(F); nv_za(F); } SEAM(2);
    if (IN(3)) { nv_proj(F, NP1, NG); } SEAM(3);
    if (IN(4)) { nv_merge(F); } SEAM(4);
    if (IN(5)) { nv_mix(F); } SEAM(5);
    if (IN(6)) { ln_phase(F, F.ln1_g, F.ln1_b, F.XN); } SEAM(6);
    if (IN(7)) { nv_up(F); } SEAM(7);
    if (IN(8)) { nv_f(F); } SEAM(8);
    if (IN(9)) { nv_down(F); } SEAM(9);
    if (IN(10)) { ln_phase(F, F.ln2_g, F.ln2_b, nullptr); }
#undef IN
#undef SEAM
}

extern "C" void kernel_launch(void* const* d_in, const int* in_sizes, int n_in, void* d_out, int out_size, void* d_ws, size_t ws_size, hipStream_t stream) {
    static int grid = 0;
    if (grid == 0) {
        if (n_in != 20 || in_sizes[0] != M * D || out_size != M * D || ws_size < WS_END) { fprintf(stderr, "kernel_launch: unexpected shapes (n_in %d out %d ws %zu); nothing launched\n", n_in, out_size, ws_size); grid = -1; return; }
        int dev = 0, cus = 0, per_cu = 0;
        if (hipGetDevice(&dev) != hipSuccess || hipDeviceGetAttribute(&cus, hipDeviceAttributeMultiprocessorCount, dev) != hipSuccess) { grid = -1; return; }
        if (hipFuncSetAttribute((const void*)mk_fwd, hipFuncAttributeMaxDynamicSharedMemorySize, LDS_BYTES) != hipSuccess) { fprintf(stderr, "kernel_launch: hipFuncSetAttribute failed\n"); grid = -1; return; }
        if (hipOccupancyMaxActiveBlocksPerMultiprocessor(&per_cu, (const void*)mk_fwd, NTHREADS, LDS_BYTES) != hipSuccess || per_cu < 1) { fprintf(stderr, "kernel_launch: occupancy query says %d workgroups per CU\n", per_cu); per_cu = 1; }
        (void)hipGetLastError();
        grid = cus;
    }
    if (grid < 0) return;
    if (hipMemsetAsync((char*)d_ws + WS_CTL, 0, CTL_ZERO_BYTES, stream) != hipSuccess) { fprintf(stderr, "kernel_launch: memset failed\n"); return; }
    Args a{};
    for (int i = 0; i < 20; ++i) a.in[i] = (const float*)d_in[i];
    a.out = (float*)d_out; a.ws = (unsigned char*)d_ws; a.ph_lo = 0; a.ph_hi = NPHASE;
    hipLaunchKernelGGL(mk_fwd, dim3(grid), dim3(NTHREADS), LDS_BYTES, stream, a);
}
```

```cpp
#include <hip/hip_runtime.h>
#include <cstdio>
#include <cstdint>

typedef unsigned short bf16;
typedef unsigned v4u __attribute__((ext_vector_type(4)));
typedef float f32x4 __attribute__((ext_vector_type(4)));

constexpr int BATCH = 2, SEQ = 8192, D = 1024, M = BATCH * SEQ;
constexpr int DQKV = 1536, DFF = 2816, NIN = 9728, NP1 = 7680, NG = 2048, NUP = 2 * DFF;
constexpr int OFF_B = 0, OFF_C = 1024, OFF_H = 2048, OFF_Q = 3072, OFF_K = 4608, OFF_V = 6144, OFF_GA = 7680, OFF_GB = 8704;
constexpr float LN_EPS = 1e-5f;
constexpr float ALPHA = 1.189207115002721f;
constexpr float LOG2E = 1.4426950408889634f;
constexpr float QSCALE = 0.125f * LOG2E;

constexpr size_t MiB = 1u << 20;
constexpr size_t WS_CTL = 0;
constexpr size_t WS_ST0 = 512 * 1024;
constexpr size_t WS_BIASP = 640 * 1024;
constexpr size_t WS_BUPP = 704 * 1024;
constexpr size_t WS_WUP = 1 * MiB;
constexpr size_t WS_WDN = 12 * MiB;
constexpr size_t WS_WIN = 18 * MiB;
constexpr size_t WS_WAB = 37 * MiB;
constexpr size_t WS_WO = 40 * MiB;
constexpr size_t WS_XN = 42 * MiB;
constexpr size_t WS_ZC = 74 * MiB;
constexpr size_t WS_U = 122 * MiB;
constexpr size_t WS_Q = 154 * MiB;
constexpr size_t WS_K = 202 * MiB;
constexpr size_t WS_G = 122 * MiB;
constexpr size_t WS_MG = 202 * MiB;
constexpr size_t WS_A1 = 74 * MiB;
constexpr size_t WS_GT = 162 * MiB;
constexpr size_t WS_LSE = 250 * MiB;
constexpr size_t WS_END = 252 * MiB;

__device__ __forceinline__ float bf2f(bf16 v) { return __uint_as_float((unsigned)v << 16); }
__device__ __forceinline__ unsigned f2bf(float f) { unsigned u = __float_as_uint(f); return (u + 0x7fffu + ((u >> 16) & 1u)) >> 16; }
__device__ __forceinline__ unsigned pk2(float lo, float hi) { return f2bf(lo) | (f2bf(hi) << 16); }

__host__ __device__ __forceinline__ int win_row(int n) {
    if (n >= OFF_C && n < OFF_H) { const int c = n - OFF_C; return 1024 + 256 * (c >> 7) + (c & 127); }
    if (n >= OFF_H && n < OFF_Q) { const int c = n - OFF_H; return 1024 + 256 * (c >> 7) + 128 + (c & 127); }
    return n;
}
__host__ __device__ __forceinline__ int wup_row(int n) {
    if (n < DFF) return 256 * (n >> 7) + (n & 127);
    const int c = n - DFF; return 256 * (c >> 7) + 128 + (c & 127);
}

#define GAS __attribute__((address_space(1)))
#define LAS __attribute__((address_space(3)))
typedef GAS unsigned gu32;
#define RLX_AGENT __ATOMIC_RELAXED, __HIP_MEMORY_SCOPE_AGENT
#define LDS_WAIT() asm volatile("s_waitcnt lgkmcnt(0)" ::: "memory")
#define VM_WAIT() asm volatile("s_waitcnt vmcnt(0)" ::: "memory")

constexpr int NWAVES = 8, NTHREADS = NWAVES * 64;
constexpr size_t CTL_ZERO_BYTES = 256 * 1024;
constexpr int CW_BAR = 4096;
constexpr int RING_OFF = 0, RING_BYTES = 131072;
constexpr int LDSCTL_OFF = RING_BYTES, MISC_OFF = LDSCTL_OFF + 320;
constexpr int LDS_BYTES = 147456;

#define XB_TMO      128
#define XB_XCNT(j)  (256  + 64 * (j))
#define XB_XSUB(j)  (1280 + 64 * (j))
#define XB_XGEN(j)  (2304 + 64 * (j))
#define XB_TOP      3328
#define XB_TOPGEN   3392
#define XCD_BAR_WORDS 3456
#define XB_SPIN_CAP (1u << 18)
__device__ __forceinline__ unsigned xb_ld(unsigned* p)              { return __hip_atomic_load(p, __ATOMIC_RELAXED, __HIP_MEMORY_SCOPE_AGENT); }
__device__ __forceinline__ unsigned xb_add(unsigned* p, unsigned v) { return __hip_atomic_fetch_add(p, v, __ATOMIC_RELAXED, __HIP_MEMORY_SCOPE_AGENT); }
__device__ __forceinline__ unsigned xb_xcc_id() { return (unsigned)__builtin_amdgcn_s_getreg((3 << 11) | 20) & 0xFu; }
#define XB_SPIN(cond, bar) do { unsigned _sp = 0; while (cond) { __builtin_amdgcn_s_sleep(1); \
    if ((++_sp & 255u) == 0u) { if (xb_ld(&(bar)[XB_TMO])) break; if (_sp > XB_SPIN_CAP) { atomicAdd(&(bar)[XB_TMO], 1u); break; } } } } while (0)
struct XcdBarrier { unsigned* bar; unsigned x; volatile LAS unsigned* st; };
__device__ __forceinline__ XcdBarrier xcd_barrier_post(unsigned* bar, volatile LAS unsigned* st) {
    XcdBarrier b; b.bar = bar; b.x = xb_xcc_id(); b.st = st;
    if (threadIdx.x == 0) (void)xb_add(&bar[XB_XCNT(b.x)], 1u);
    return b;
}
__device__ __forceinline__ void xcd_barrier_complete(unsigned* bar, unsigned x, unsigned& nloc, unsigned& nx) {
    const unsigned G = gridDim.x * gridDim.y * gridDim.z;
    unsigned sum, cnt, mine, sp = 0u;
    for (;;) {
        sum = 0u; cnt = 0u; mine = 0u;
#pragma unroll
        for (unsigned j = 0; j < 16; ++j) { const unsigned c = xb_ld(&bar[XB_XCNT(j)]); sum += c; cnt += (c > 0u) ? 1u : 0u; mine = (j == x) ? c : mine; }
        if (sum == G) break;
        __builtin_amdgcn_s_sleep(1);
        if ((++sp & 255u) == 0u) { if (xb_ld(&bar[XB_TMO])) break; if (sp > XB_SPIN_CAP) { atomicAdd(&bar[XB_TMO], 1u); break; } }
    }
    nloc = mine > 0u ? mine : 1u; nx = cnt > 0u ? cnt : 1u;
}
__device__ __forceinline__ void xcd_barrier(const XcdBarrier& b) {
    asm volatile("s_waitcnt vmcnt(0)" ::: "memory");
    __syncthreads();
    if (threadIdx.x == 0) {
        unsigned* bar = b.bar;
        __builtin_amdgcn_s_waitcnt(0);
        unsigned nloc = b.st[0], nx = b.st[1];
        if (nloc == 0u) { xcd_barrier_complete(bar, b.x, nloc, nx); b.st[0] = nloc; b.st[1] = nx; }
        const unsigned old = xb_add(&bar[XB_XSUB(b.x)], 1u);
        const unsigned gen = old / nloc;
        if (old + 1u == (gen + 1u) * nloc) {
            __builtin_amdgcn_fence(__ATOMIC_RELEASE, "agent");
            asm volatile("s_waitcnt vmcnt(0)" ::: "memory");
            const unsigned og = xb_add(&bar[XB_TOP], 1u);
            const unsigned tg = og / nx;
            if (og + 1u == (tg + 1u) * nx) xb_add(&bar[XB_TOPGEN], 1u);
            else XB_SPIN(xb_ld(&bar[XB_TOPGEN]) == tg, bar);
            __builtin_amdgcn_fence(__ATOMIC_ACQUIRE, "agent");
            xb_add(&bar[XB_XGEN(b.x)], 1u);
            asm volatile("s_waitcnt vmcnt(0)" ::: "memory");
        } else {
            XB_SPIN(xb_ld(&bar[XB_XGEN(b.x)]) == gen, bar);
            __builtin_amdgcn_fence(__ATOMIC_ACQUIRE, "agent");
            asm volatile("s_waitcnt vmcnt(0)" ::: "memory");
        }
    }
    __syncthreads();
}

namespace pg8 {
#define PG8_LAS __attribute__((address_space(3)))
typedef unsigned short bf16_t;
typedef short bf16x8 __attribute__((ext_vector_type(8)));
typedef float f32x4 __attribute__((ext_vector_type(4)));
typedef unsigned u32x4 __attribute__((ext_vector_type(4)));
constexpr int BM = 256, BK = 64, HALF = 128, HTB = HALF * BK * 2  , STAGE_BYTES = 8 * HTB, NXCD = 8, WGM = 8;

__host__ __device__ __forceinline__ int lds_byte(int r, int c) { const int st = (r >> 4) * 2 + (c >> 5), rr = r & 15, cc = c & 31, ob = rr * 64 + cc * 2; return st * 1024 + (ob ^ (((ob >> 9) & 1) << 5)); }
__host__ __device__ __forceinline__ void stage_rc(int b, int& R, int& C) { const int st = b / 1024, sb = b % 1024, swz = sb ^ (((sb >> 9) & 1) << 5); R = (st >> 1) * 16 + swz / 64; C = (st & 1) * 32 + (swz % 64) / 2; }
__host__ __device__ __forceinline__ int perm32(int rho) { const int n = rho >> 4, i = rho & 15; return 8 * (i >> 2) + 4 * n + (i & 3); }

struct Unit { int pm, pn; };
struct Gemm { const bf16_t* A; const bf16_t* Bt; int M, N, K; };

struct StaticOrder {
    int nM, nN, nwg, G, c;
    __host__ __device__ void init(int M, int N, int G_, int c_) { nM = M / BM; nN = N / BM; nwg = nM * nN; G = G_; c = c_; }
    __host__ __device__ bool next(int i, Unit& u) const {
        const long L = (long)i * G + c; if (L >= nwg) return false;
        int wgid = (int)L; { const int q = nwg / NXCD, r = nwg % NXCD, xcd = wgid % NXCD, off = wgid / NXCD; wgid = (xcd < r ? xcd * (q + 1) : r * (q + 1) + (xcd - r) * q) + off; }
        const int nig = WGM * nN, gid = wgid / nig, fm = gid * WGM, gsz = (nM - fm) < WGM ? (nM - fm) : WGM;
        u.pm = fm + ((wgid % nig) % gsz); u.pn = (wgid % nig) / gsz; return true;
    }
    __device__ __forceinline__ void a_ready(const Unit&) const {}
    __device__ __forceinline__ void done(const Unit&) const {}
};

typedef float f32x2_cv __attribute__((ext_vector_type(2))); typedef __bf16 bf16x2_cv __attribute__((ext_vector_type(2)));
__device__ __forceinline__ unsigned cvt_pk_bf16(float lo, float hi) { const f32x2_cv v = {lo, hi}; const bf16x2_cv b = __builtin_convertvector(v, bf16x2_cv); return __builtin_bit_cast(unsigned, b); }
typedef float f32x2 __attribute__((ext_vector_type(2)));
__device__ __forceinline__ f32x2 gelu_pk(f32x2 v) {
    const f32x2 av = __builtin_elementwise_abs(v), d = av * 0.2316418882f + 1.0f;
    f32x2 t; t.x = __builtin_amdgcn_rcpf(d.x); t.y = __builtin_amdgcn_rcpf(d.y);
    f32x2 q = t * 0.5307027145f + (-0.7265760135f); q = q * t + 0.7107068705f; q = q * t + (-0.142248368f); q = q * t + 0.127414796f; q = q * t;
    const f32x2 s = (v * v) * (-0.72134752044f);
    f32x2 e; e.x = __builtin_amdgcn_exp2f(s.x); e.y = __builtin_amdgcn_exp2f(s.y);
    const f32x2 m = v * (q * e), r = v - m;
    f32x2 o; o.x = v.x < 0.f ? m.x : r.x; o.y = v.y < 0.f ? m.y : r.y; return o;
}


typedef unsigned u32x2 __attribute__((ext_vector_type(2)));
__device__ __forceinline__ u32x4 pack8(const f32x4 v0, const f32x4 v1) { u32x4 w; w.x = cvt_pk_bf16(v0[0], v0[1]); w.y = cvt_pk_bf16(v0[2], v0[3]); w.z = cvt_pk_bf16(v1[0], v1[1]); w.w = cvt_pk_bf16(v1[2], v1[3]); return w; }
__device__ __forceinline__ float bflo(unsigned w) { return __uint_as_float(w << 16); }
__device__ __forceinline__ float bfhi(unsigned w) { return __uint_as_float(w & 0xffff0000u); }
struct EpiProj {
    static constexpr bool PERM = true, AFTER_DRAIN = false; static constexpr int MIDK = 0;
    bf16_t *ZC, *U, *Q, *K, *V; const float* bias; float qscale;
    __device__ __forceinline__ void operator()(const f32x4 (&acc)[2][2][4][2], const Unit& u, int wr, int wc, int fr, int fq) const {
        const int row0 = u.pm * BM + wr * 64 + fr, cw = wc * 32 + 8 * fq, pn = u.pn;
        f32x4 bv[2][2];
#pragma unroll
        for (int bj = 0; bj < 2; ++bj)
#pragma unroll
            for (int n = 0; n < 2; ++n) bv[bj][n] = *(const f32x4*)(bias + pn * BM + bj * HALF + cw + 4 * n);
        if (pn >= 4 && pn < 12) {
            bf16_t* base = U + (pn - 4) * HALF + cw;
#pragma unroll
            for (int ai = 0; ai < 2; ++ai)
#pragma unroll
                for (int m = 0; m < 4; ++m) { bf16_t* rowp = base + (size_t)(row0 + ai * HALF + m * 16) * 1024;
                    const f32x4 v0 = (acc[ai][0][m][0] + bv[0][0]) * (acc[ai][1][m][0] + bv[1][0]), v1 = (acc[ai][0][m][1] + bv[0][1]) * (acc[ai][1][m][1] + bv[1][1]);
                    *(u32x4*)rowp = pack8(v0, v1); }
            return;
        }
        bf16_t* base; int ldc; float sc = 1.f;
        if (pn < 4) { base = ZC + pn * BM; ldc = 1536; }
        else if (pn < 18) { base = Q + (pn - 12) * BM; ldc = 1536; sc = qscale; }
        else if (pn < 24) { base = K + (pn - 18) * BM; ldc = 1536; }
        else { base = V + (pn - 24) * BM; ldc = 1536; }
        base += cw;
#pragma unroll
        for (int ai = 0; ai < 2; ++ai)
#pragma unroll
            for (int m = 0; m < 4; ++m) { bf16_t* rowp = base + (size_t)(row0 + ai * HALF + m * 16) * ldc;
#pragma unroll
                for (int bj = 0; bj < 2; ++bj) *(u32x4*)(rowp + bj * HALF) = pack8((acc[ai][bj][m][0] + bv[bj][0]) * sc, (acc[ai][bj][m][1] + bv[bj][1]) * sc); }
    }
};
struct EpiSig {
    static constexpr bool PERM = true, AFTER_DRAIN = false; static constexpr int MIDK = 0;
    bf16_t* G; const float* bias;
    __device__ __forceinline__ void operator()(const f32x4 (&acc)[2][2][4][2], const Unit& u, int wr, int wc, int fr, int fq) const {
        const int row0 = u.pm * BM + wr * 64 + fr, col0 = u.pn * BM + wc * 32 + 8 * fq;
        f32x4 bv[2][2];
#pragma unroll
        for (int bj = 0; bj < 2; ++bj)
#pragma unroll
            for (int n = 0; n < 2; ++n) bv[bj][n] = *(const f32x4*)(bias + col0 + bj * HALF + 4 * n);
#pragma unroll
        for (int ai = 0; ai < 2; ++ai)
#pragma unroll
            for (int m = 0; m < 4; ++m) { bf16_t* rowp = G + (size_t)(row0 + ai * HALF + m * 16) * 2048 + col0;
#pragma unroll
                for (int bj = 0; bj < 2; ++bj) { f32x4 v[2];
#pragma unroll
                    for (int n = 0; n < 2; ++n) { const f32x4 x = acc[ai][bj][m][n] + bv[bj][n];
#pragma unroll
                        for (int j = 0; j < 4; ++j) v[n][j] = __builtin_amdgcn_rcpf(1.0f + __builtin_amdgcn_exp2f(x[j] * -1.4426950408889634f)); }
                    *(u32x4*)(rowp + bj * HALF) = pack8(v[0], v[1]); } }
    }
};
struct EpiMerge {
    static constexpr bool PERM = true, AFTER_DRAIN = false; static constexpr int MIDK = 16;
    const bf16_t* G; bf16_t* MG;
    __device__ __forceinline__ void mid(f32x4 (&acc)[2][2][4][2], const Unit& u, int wr, int wc, int fr, int fq) const {
        const char* Gb = (const char*)G;
        asm volatile("" : "+v"(fr), "+v"(fq));
        const unsigned off0 = ((unsigned)(u.pm * BM + wr * 64 + fr) * 2048u + (unsigned)(u.pn * BM + wc * 32 + 8 * fq)) * 2u;
#pragma unroll
        for (int ai = 0; ai < 2; ++ai)
#pragma unroll
            for (int m = 0; m < 4; ++m)
#pragma unroll
                for (int bj = 0; bj < 2; ++bj) { const unsigned off = off0 + (unsigned)((ai * HALF + m * 16) * 2048 + bj * HALF) * 2u;
                    const u32x4 ga = *(const u32x4*)(Gb + off), gb = *(const u32x4*)(Gb + off + 2048u);
#pragma unroll
                    for (int w = 0; w < 4; ++w) { const float r0 = bflo(ga[w]) * __builtin_amdgcn_rcpf(bflo(gb[w])), r1 = bfhi(ga[w]) * __builtin_amdgcn_rcpf(bfhi(gb[w]));
                        acc[ai][bj][m][w >> 1][(w & 1) * 2] *= r0; acc[ai][bj][m][w >> 1][(w & 1) * 2 + 1] *= r1; }
                    asm volatile("" ::: "memory"); }
    }
    __device__ __forceinline__ void operator()(const f32x4 (&acc)[2][2][4][2], const Unit& u, int wr, int wc, int fr, int fq) const {
        asm volatile("" : "+v"(fr), "+v"(fq));
        const int row0 = u.pm * BM + wr * 64 + fr, col0 = u.pn * BM + wc * 32 + 8 * fq;
#pragma unroll
        for (int ai = 0; ai < 2; ++ai)
#pragma unroll
            for (int m = 0; m < 4; ++m) { const size_t ro = (size_t)(row0 + ai * HALF + m * 16);
#pragma unroll
                for (int bj = 0; bj < 2; ++bj) { const u32x4 gb = *(const u32x4*)(G + ro * 2048 + 1024 + col0 + bj * HALF);
                    const f32x4 g0 = {bflo(gb[0]), bfhi(gb[0]), bflo(gb[1]), bfhi(gb[1])}, g1 = {bflo(gb[2]), bfhi(gb[2]), bflo(gb[3]), bfhi(gb[3])};
                    *(u32x4*)(MG + ro * 1024 + col0 + bj * HALF) = pack8(acc[ai][bj][m][0] * g0, acc[ai][bj][m][1] * g1); } }
    }
};
struct EpiMix {
    static constexpr bool PERM = false, AFTER_DRAIN = false; static constexpr int MIDK = 0;
    const float *x, *st, *g0, *b0, *bo; float* R1; float alpha;
    __device__ __forceinline__ void operator()(const f32x4 (&acc)[2][2][4][2], const Unit& u, int wr, int wc, int fr, int fq) const {
        const int row0 = u.pm * BM + wr * 64 + fr, col0 = u.pn * BM + wc * 32 + 4 * fq;
        f32x4 gv[2][2], bv[2][2];
#pragma unroll
        for (int bj = 0; bj < 2; ++bj)
#pragma unroll
            for (int n = 0; n < 2; ++n) { const int c = col0 + bj * HALF + n * 16; gv[bj][n] = *(const f32x4*)(g0 + c) * alpha; bv[bj][n] = *(const f32x4*)(b0 + c) * alpha + *(const f32x4*)(bo + c); }
#pragma unroll
        for (int ai = 0; ai < 2; ++ai)
#pragma unroll
            for (int m = 0; m < 4; ++m) { const size_t ro = (size_t)(row0 + ai * HALF + m * 16); const float mean = st[2 * ro], rstd = st[2 * ro + 1];
#pragma unroll
                for (int bj = 0; bj < 2; ++bj)
#pragma unroll
                    for (int n = 0; n < 2; ++n) { const size_t off = ro * 1024 + col0 + bj * HALF + n * 16; const f32x4 xv = *(const f32x4*)(x + off);
                        *(f32x4*)(R1 + off) = (xv - mean) * rstd * gv[bj][n] + bv[bj][n] + acc[ai][bj][m][n]; } }
    }
};
struct EpiUp {
    static constexpr bool PERM = true, AFTER_DRAIN = false; static constexpr int MIDK = 0;
    bf16_t *A1, *GT; const float* bias;
    __device__ __forceinline__ void operator()(const f32x4 (&acc)[2][2][4][2], const Unit& u, int wr, int wc, int fr, int fq) const {
        const int row0 = u.pm * BM + wr * 64 + fr, cw = wc * 32 + 8 * fq, ch0 = u.pn * HALF + cw;
        f32x4 bv[2][2];
#pragma unroll
        for (int bj = 0; bj < 2; ++bj)
#pragma unroll
            for (int n = 0; n < 2; ++n) bv[bj][n] = *(const f32x4*)(bias + u.pn * BM + bj * HALF + cw + 4 * n);
#pragma unroll
        for (int ai = 0; ai < 2; ++ai)
#pragma unroll
            for (int m = 0; m < 4; ++m) { const size_t ro = (size_t)(row0 + ai * HALF + m * 16) * 2816 + ch0;
                *(u32x4*)(A1 + ro) = pack8(acc[ai][0][m][0] + bv[0][0], acc[ai][0][m][1] + bv[0][1]);
                *(u32x4*)(GT + ro) = pack8(acc[ai][1][m][0] + bv[1][0], acc[ai][1][m][1] + bv[1][1]); }
    }
};
struct EpiDown {
    static constexpr bool PERM = false, AFTER_DRAIN = false; static constexpr int MIDK = 0;
    float* H; const float* bd; float alpha;
    __device__ __forceinline__ void operator()(const f32x4 (&acc)[2][2][4][2], const Unit& u, int wr, int wc, int fr, int fq) const {
        const int row0 = u.pm * BM + wr * 64 + fr, col0 = u.pn * BM + wc * 32 + 4 * fq;
        f32x4 bv[2][2];
#pragma unroll
        for (int bj = 0; bj < 2; ++bj)
#pragma unroll
            for (int n = 0; n < 2; ++n) bv[bj][n] = *(const f32x4*)(bd + col0 + bj * HALF + n * 16);
#pragma unroll
        for (int ai = 0; ai < 2; ++ai)
#pragma unroll
            for (int m = 0; m < 4; ++m) { const size_t ro = (size_t)(row0 + ai * HALF + m * 16) * 1024 + col0;
#pragma unroll
                for (int bj = 0; bj < 2; ++bj)
#pragma unroll
                    for (int n = 0; n < 2; ++n) { float* p = H + ro + bj * HALF + n * 16; *(f32x4*)p = *(const f32x4*)p * alpha + acc[ai][bj][m][n] + bv[bj][n]; } }
    }
};

template <class Epi, class Sched, bool ALIGN_EPI = false, bool SP2 = false>
__device__ __forceinline__ void gemm_phase(PG8_LAS unsigned char* lds, const Gemm g, const Sched& S, const Epi& E) {
    const int tid = threadIdx.x, wid = __builtin_amdgcn_readfirstlane(tid >> 6), lane = tid & 63, wr = wid >> 2, wc = wid & 3, fr = lane & 15, fq = lane >> 4;
    const int K = g.K, nt = K / BK;
    unsigned voffA[2], voffB[2];
#pragma unroll
    for (int i = 0; i < 2; ++i) { int R, C; stage_rc(tid * 16 + i * 8192, R, C); const int Rb = Epi::PERM ? ((R & ~31) + perm32(R & 31)) : R;
        voffA[i] = (unsigned)(R * K + C) * 2u; voffB[i] = (unsigned)(Rb * K + C) * 2u; }
    const size_t kstep = (size_t)(BK * 2);
    const size_t hstep = (size_t)HALF * K * 2;
    const size_t tstep = 2 * hstep;
    const unsigned ldsw = (unsigned)wid * 1024u;
    const int aoff = lds_byte(wr * 64 + fr, fq * 8), boff = lds_byte(wc * 32 + fr, fq * 8);
#define PG8_SA(b, h) (((b) * 2 + (h)) * HTB)
#define PG8_SB(b, h) ((4 + (b) * 2 + (h)) * HTB)
#define PG8_STAGE(bufoff, gbase, voff) do { _Pragma("unroll") for (int _i = 0; _i < 2; ++_i) \
        __builtin_amdgcn_global_load_lds((const unsigned*)((const char*)(gbase) + (voff)[_i]), (PG8_LAS unsigned*)(lds + (bufoff) + ldsw + _i * 8192), 16, 0, 0); } while (0)
#define PG8_LDA(dst, b, h) do { _Pragma("unroll") for (int m = 0; m < 4; ++m) _Pragma("unroll") for (int k = 0; k < 2; ++k) dst[m][k] = *(const PG8_LAS bf16x8*)(lds + PG8_SA(b, h) + aoff + m * 2048 + k * 1024); } while (0)
#define PG8_LDB(dst, b, h) do { _Pragma("unroll") for (int n = 0; n < 2; ++n) _Pragma("unroll") for (int k = 0; k < 2; ++k) dst[n][k] = *(const PG8_LAS bf16x8*)(lds + PG8_SB(b, h) + boff + n * 2048 + k * 1024); } while (0)
#define PG8_MMA(ai, bj, At, Bt) do { __builtin_amdgcn_s_setprio(1); _Pragma("unroll") for (int m = 0; m < 4; ++m) _Pragma("unroll") for (int n = 0; n < 2; ++n) _Pragma("unroll") for (int k = 0; k < 2; ++k) \
        acc[ai][bj][m][n] = __builtin_amdgcn_mfma_f32_16x16x32_bf16(Bt[n][k], At[m][k], acc[ai][bj][m][n], 0, 0, 0); __builtin_amdgcn_s_setprio(0); } while (0)
#define PG8_WAIT_V(n) asm volatile("s_waitcnt vmcnt(" #n ")" ::: "memory")
#define PG8_WAIT_L(n) asm volatile("s_waitcnt lgkmcnt(" #n ")" ::: "memory")
#define PG8_BAR __builtin_amdgcn_s_barrier()
#define PG8_SCHED __builtin_amdgcn_sched_barrier(0)
    Unit cur, nxt; int ui = 0;
    if (!S.next(0, cur)) return;
    f32x4 acc[2][2][4][2];
#pragma unroll
    for (int a = 0; a < 2; ++a)
#pragma unroll
        for (int b = 0; b < 2; ++b)
#pragma unroll
            for (int m = 0; m < 4; ++m)
#pragma unroll
                for (int n = 0; n < 2; ++n) acc[a][b][m][n] = (f32x4){0.f, 0.f, 0.f, 0.f};
    bf16x8 At[4][2], B0[2][2], B1[2][2];
    const char* cA = (const char*)g.A + (size_t)cur.pm * tstep; const char* cB = (const char*)g.Bt + (size_t)cur.pn * tstep;
    S.a_ready(cur);
    if constexpr (SP2) {
        PG8_STAGE(PG8_SB(0, 0), cB, voffB); PG8_STAGE(PG8_SB(0, 1), cB + hstep, voffB); PG8_STAGE(PG8_SA(0, 0), cA, voffA); PG8_STAGE(PG8_SA(0, 1), cA + hstep, voffA);
        if (wr == 1) PG8_BAR;
        PG8_WAIT_V(2); PG8_BAR;
        PG8_STAGE(PG8_SB(1, 0), cB + kstep, voffB); PG8_STAGE(PG8_SA(1, 0), cA + kstep, voffA); PG8_STAGE(PG8_SB(1, 1), cB + hstep + kstep, voffB);
        PG8_WAIT_V(6); PG8_BAR;
    } else {
        PG8_STAGE(PG8_SB(0, 0), cB, voffB); PG8_STAGE(PG8_SA(0, 0), cA, voffA); PG8_STAGE(PG8_SB(0, 1), cB + hstep, voffB); PG8_STAGE(PG8_SA(0, 1), cA + hstep, voffA);
        if (wr == 1) PG8_BAR;
        PG8_WAIT_V(4); PG8_BAR;
        PG8_STAGE(PG8_SB(1, 0), cB + kstep, voffB); PG8_STAGE(PG8_SA(1, 0), cA + kstep, voffA); PG8_STAGE(PG8_SB(1, 1), cB + hstep + kstep, voffB);
        PG8_WAIT_V(6); PG8_BAR;
    }
    for (;;) {
        const bool has_next = S.next(ui + 1, nxt);
        const char* nA = has_next ? (const char*)g.A + (size_t)nxt.pm * tstep : cA; const char* nB = has_next ? (const char*)g.Bt + (size_t)nxt.pn * tstep : cB;
        constexpr int NSEG = Epi::MIDK > 0 ? 2 : 1;
        for (int seg = 0; seg < NSEG; ++seg) {
        const int tb = (seg == 0) ? 0 : Epi::MIDK, te = (NSEG == 2 && seg == 0) ? Epi::MIDK : nt;
        for (int t = tb; t < te; t += 2) {
            const bool last = (t == nt - 2);
            const char* a1 = cA + (size_t)(t + 1) * kstep;
            const char* a2 = last ? nA : cA + (size_t)(t + 2) * kstep; const char* b2 = last ? nB : cB + (size_t)(t + 2) * kstep;
            const char* a3 = a2 + kstep; const char* b3 = b2 + kstep;
            if (last && has_next) S.a_ready(nxt);
            if constexpr (SP2) {
            PG8_LDB(B0, 0, 0); PG8_LDB(B1, 0, 1); PG8_SCHED; PG8_LDA(At, 0, 0); PG8_STAGE(PG8_SA(1, 1), a1 + hstep, voffA);
            PG8_WAIT_V(8); PG8_WAIT_L(0); PG8_BAR; PG8_MMA(0, 0, At, B0); PG8_MMA(0, 1, At, B1); PG8_BAR; PG8_SCHED;
            PG8_LDA(At, 0, 1); PG8_STAGE(PG8_SB(0, 0), b2, voffB); PG8_STAGE(PG8_SB(0, 1), b2 + hstep, voffB); PG8_STAGE(PG8_SA(0, 0), a2, voffA);
            PG8_WAIT_V(8); PG8_WAIT_L(0); PG8_BAR; PG8_MMA(1, 0, At, B0); PG8_MMA(1, 1, At, B1); PG8_BAR; PG8_SCHED;
            PG8_LDB(B0, 1, 0); PG8_LDB(B1, 1, 1); PG8_SCHED; PG8_LDA(At, 1, 0); PG8_STAGE(PG8_SA(0, 1), a2 + hstep, voffA);
            PG8_WAIT_V(8); PG8_WAIT_L(0); PG8_BAR; PG8_MMA(0, 0, At, B0); PG8_MMA(0, 1, At, B1); PG8_BAR; PG8_SCHED;
            PG8_LDA(At, 1, 1); PG8_STAGE(PG8_SB(1, 0), b3, voffB); PG8_STAGE(PG8_SB(1, 1), b3 + hstep, voffB); PG8_STAGE(PG8_SA(1, 0), a3, voffA);
            PG8_WAIT_V(8); PG8_WAIT_L(0); PG8_BAR; PG8_MMA(1, 0, At, B0); PG8_MMA(1, 1, At, B1); PG8_BAR; PG8_SCHED;
            } else {
            PG8_LDB(B0, 0, 0); PG8_SCHED; PG8_LDA(At, 0, 0); PG8_STAGE(PG8_SA(1, 1), a1 + hstep, voffA);
            PG8_WAIT_L(8); PG8_BAR; PG8_WAIT_L(0); PG8_MMA(0, 0, At, B0); PG8_BAR; PG8_SCHED;
            PG8_LDB(B1, 0, 1); PG8_STAGE(PG8_SB(0, 0), b2, voffB);
            PG8_BAR; PG8_WAIT_L(0); PG8_MMA(0, 1, At, B1); PG8_BAR;
            PG8_LDA(At, 0, 1); PG8_STAGE(PG8_SA(0, 0), a2, voffA);
            PG8_BAR; PG8_WAIT_L(0); PG8_MMA(1, 0, At, B0); PG8_BAR; PG8_SCHED;
            PG8_STAGE(PG8_SB(0, 1), b2 + hstep, voffB);
            PG8_WAIT_V(6); PG8_BAR; PG8_MMA(1, 1, At, B1); PG8_BAR;
            PG8_LDB(B0, 1, 0); PG8_SCHED; PG8_LDA(At, 1, 0); PG8_STAGE(PG8_SA(0, 1), a2 + hstep, voffA);
            PG8_WAIT_L(8); PG8_BAR; PG8_WAIT_L(0); PG8_MMA(0, 0, At, B0); PG8_BAR; PG8_SCHED;
            PG8_LDB(B1, 1, 1); PG8_STAGE(PG8_SB(1, 0), b3, voffB);
            PG8_BAR; PG8_WAIT_L(0); PG8_MMA(0, 1, At, B1); PG8_BAR;
            PG8_LDA(At, 1, 1); PG8_STAGE(PG8_SA(1, 0), a3, voffA);
            PG8_BAR; PG8_WAIT_L(0); PG8_MMA(1, 0, At, B0); PG8_BAR; PG8_SCHED;
            PG8_STAGE(PG8_SB(1, 1), b3 + hstep, voffB);
            PG8_WAIT_V(6); PG8_BAR; PG8_MMA(1, 1, At, B1); PG8_BAR;
            }
        }
        if constexpr (Epi::MIDK > 0) { if (seg == 0) E.mid(acc, cur, wr, wc, fr, fq); }
        }
        if constexpr (ALIGN_EPI) { if (wr == 0) PG8_BAR; }
        if constexpr (!Epi::AFTER_DRAIN) { E(acc, cur, wr, wc, fr, fq); S.done(cur); }
        if (!has_next) break;
#pragma unroll
        for (int a = 0; a < 2; ++a)
#pragma unroll
            for (int b = 0; b < 2; ++b)
#pragma unroll
                for (int m = 0; m < 4; ++m)
#pragma unroll
                    for (int n = 0; n < 2; ++n) acc[a][b][m][n] = (f32x4){0.f, 0.f, 0.f, 0.f};
        cur = nxt; cA = nA; cB = nB; ++ui;
        if constexpr (ALIGN_EPI) { if (wr == 1) PG8_BAR; }
    }
    PG8_WAIT_V(0);
    if constexpr (!ALIGN_EPI) { if (wr == 0) PG8_BAR; }
    PG8_BAR;
    if constexpr (Epi::AFTER_DRAIN) { E.fused(acc, cur, wr, wc, fr, fq, lds, wid, lane); S.done(cur); }
#undef PG8_SA
#undef PG8_SB
#undef PG8_STAGE
#undef PG8_LDA
#undef PG8_LDB
#undef PG8_MMA
#undef PG8_WAIT_V
#undef PG8_WAIT_L
#undef PG8_BAR
#undef PG8_SCHED
}
}

struct Frame {
    LAS unsigned char* lds; volatile LAS unsigned* MISC; gu32* ctl;
    int tid, lane, wave, vcu, G;
    const float *x, *ln0_g, *ln0_b, *w_in, *b_in, *conv_w, *w_a, *w_b, *w_o, *b_o, *ln1_g, *ln1_b, *w_up, *b_up, *fcw, *fcb, *w_dn, *b_dn, *ln2_g, *ln2_b;
    float* out; float *ST0, *BIASP, *BUPP, *LSE;
    bf16 *WUP, *WDN, *WIN, *WAB, *WO, *XN, *ZC, *U, *Q, *KB, *VB, *G_, *MG, *A1, *GT;
};
__device__ __forceinline__ float wave_sum(float v) {
#pragma unroll
    for (int o = 1; o < 64; o <<= 1) v += __shfl_xor(v, o);
    return v;
}
__device__ __forceinline__ void p0_transpose_item(const float* W, int K, int N, bf16* WT, int ldk, int koff, int mode, LAS float* scr, int item, int lane) {
    const int nblk = N / 32, kb = item / nblk, nb = item % nblk, k0 = 64 * kb, n0 = 32 * nb;
    const int r0 = mode == 1 ? win_row(n0) : mode == 2 ? wup_row(n0) : n0;
#pragma unroll 8
    for (int i = 0; i < 32; ++i) { const int kk = 2 * i + (lane >> 5); scr[kk * 33 + (lane & 31)] = W[(size_t)(k0 + kk) * N + n0 + (lane & 31)]; }
    LDS_WAIT(); asm volatile("" ::: "memory");
    const int c = lane & 7;
#pragma unroll
    for (int j = 0; j < 4; ++j) { const int n = (lane >> 3) + 8 * j; const LAS float* s = scr + (8 * c) * 33 + n;
        v4u o; o.x = pk2(s[0 * 33], s[1 * 33]); o.y = pk2(s[2 * 33], s[3 * 33]); o.z = pk2(s[4 * 33], s[5 * 33]); o.w = pk2(s[6 * 33], s[7 * 33]);
        *(GAS v4u*)(WT + (size_t)(r0 + n) * ldk + koff + k0 + 8 * c) = o; }
    LDS_WAIT(); asm volatile("" ::: "memory");
}
__device__ __forceinline__ void ln_row(const float* xrow, const float* g, const float* b, float* of32, bf16* obf, float* st, int lane) {
    const GAS f32x4* xr = (const GAS f32x4*)xrow + lane;
    f32x4 v[4]; float s = 0.f;
#pragma unroll
    for (int j = 0; j < 4; ++j) { v[j] = xr[64 * j]; s += (v[j].x + v[j].y) + (v[j].z + v[j].w); }
    const float mean = wave_sum(s) * (1.f / D); float s2 = 0.f;
#pragma unroll
    for (int j = 0; j < 4; ++j) { v[j] = v[j] - mean; s2 += (v[j].x * v[j].x + v[j].y * v[j].y) + (v[j].z * v[j].z + v[j].w * v[j].w); }
    const float rstd = 1.f / sqrtf(wave_sum(s2) * (1.f / D) + LN_EPS);
    if (st && lane == 0) { st[0] = mean; st[1] = rstd; }
#pragma unroll
    for (int j = 0; j < 4; ++j) {
        const f32x4 gg = ((const GAS f32x4*)g)[lane + 64 * j], bb = ((const GAS f32x4*)b)[lane + 64 * j];
        const f32x4 y = v[j] * rstd * gg + bb;
        if (of32) ((GAS f32x4*)of32)[lane + 64 * j] = y;
        if (obf) ((GAS unsigned long long*)obf)[lane + 64 * j] = (unsigned long long)pk2(y.x, y.y) | ((unsigned long long)pk2(y.z, y.w) << 32);
    }
}
__device__ __forceinline__ void p0_prologue(Frame& F) {
    LAS float* scr = (LAS float*)(F.lds + RING_OFF + F.wave * 16384);
    const int gw = F.vcu * NWAVES + F.wave, NGW = F.G * NWAVES;
    constexpr int I_IN = (D / 64) * (NIN / 32), I_A = (D / 64) * (D / 32), I_B = (512 / 64) * (D / 32), I_O = I_A, I_UP = (D / 64) * (NUP / 32), I_DN = (DFF / 64) * (D / 32);
    constexpr int NITEMS = I_IN + I_A + I_B + I_O + I_UP + I_DN;
    for (int it = gw; it < NITEMS; it += NGW) {
        int r = it;
        if (r < I_IN) { p0_transpose_item(F.w_in, D, NIN, F.WIN, D, 0, 1, scr, r, F.lane); continue; } r -= I_IN;
        if (r < I_A) { p0_transpose_item(F.w_a, D, D, F.WAB, 1536, 0, 0, scr, r, F.lane); continue; } r -= I_A;
        if (r < I_B) { p0_transpose_item(F.w_b, 512, D, F.WAB, 1536, 1024, 0, scr, r, F.lane); continue; } r -= I_B;
        if (r < I_O) { p0_transpose_item(F.w_o, D, D, F.WO, D, 0, 0, scr, r, F.lane); continue; } r -= I_O;
        if (r < I_UP) { p0_transpose_item(F.w_up, D, NUP, F.WUP, D, 0, 2, scr, r, F.lane); continue; } r -= I_UP;
        p0_transpose_item(F.w_dn, DFF, D, F.WDN, DFF, 0, 0, scr, r, F.lane);
    }
    for (int i = F.vcu * NTHREADS + F.tid; i < NIN; i += F.G * NTHREADS) { F.BIASP[win_row(i)] = F.b_in[i]; if (i < NUP) F.BUPP[wup_row(i)] = F.b_up[i]; }
    for (int m = gw; m < M; m += NGW) ln_row(F.x + (size_t)m * D, F.ln0_g, F.ln0_b, nullptr, F.XN + (size_t)m * D, F.ST0 + 2 * m, F.lane);
}

template <int K>
__device__ __forceinline__ void nv_dot8(const bf16* __restrict__ A, int lda, const bf16* __restrict__ Brow, float (&acc)[8]) {
#pragma unroll
    for (int r = 0; r < 8; ++r) acc[r] = 0.f;
    for (int k = 0; k < K; k += 8) {
        const v4u bv = *(const v4u*)(Brow + k);
        float bfv[8];
#pragma unroll
        for (int j = 0; j < 4; ++j) { bfv[2 * j] = __uint_as_float(bv[j] << 16); bfv[2 * j + 1] = __uint_as_float(bv[j] & 0xffff0000u); }
#pragma unroll
        for (int r = 0; r < 8; ++r) {
            const v4u av = *(const v4u*)(A + (size_t)r * lda + k);
#pragma unroll
            for (int j = 0; j < 4; ++j) { acc[r] += __uint_as_float(av[j] << 16) * bfv[2 * j]; acc[r] += __uint_as_float(av[j] & 0xffff0000u) * bfv[2 * j + 1]; }
        }
    }
}
__device__ __forceinline__ float sigmoidf_(float v) { return 1.f / (1.f + __expf(-v)); }
#define NV_LOOP(nbx, nby) for (int vb_ = 2 * (int)blockIdx.x + (F.tid >> 8); vb_ < (nbx) * (nby); vb_ += 2 * F.G)
#define NV_BX(nbx) (vb_ % (nbx))
#define NV_BY(nbx) (vb_ / (nbx))
__device__ __forceinline__ void nv_proj(Frame& F, int n_off, int ncols) {
    const int t256 = F.tid & 255, nbx = ncols / 256;
    NV_LOOP(nbx, M / 8) {
        const int n = n_off + NV_BX(nbx) * 256 + t256, row0 = NV_BY(nbx) * 8;
        if (n >= 1024 && n < 3072) {
            if (t256 < 128) {
                float ac[8], ah[8]; nv_dot8<D>(F.XN + (size_t)row0 * D, D, F.WIN + (size_t)n * D, ac); nv_dot8<D>(F.XN + (size_t)row0 * D, D, F.WIN + (size_t)(n + 128) * D, ah);
                const float bc = F.BIASP[n], bh = F.BIASP[n + 128]; const int ch = 128 * ((n - 1024) >> 8) + t256;
#pragma unroll
                for (int r = 0; r < 8; ++r) F.U[(size_t)(row0 + r) * D + ch] = (bf16)f2bf((ac[r] + bc) * (ah[r] + bh));
            }
            continue;
        }
        float acc[8]; nv_dot8<D>(F.XN + (size_t)row0 * D, D, F.WIN + (size_t)n * D, acc);
        const float bs = F.BIASP[n];
#pragma unroll
        for (int r = 0; r < 8; ++r) {
            const float v = acc[r] + bs; const size_t row = row0 + r;
            if (n < 1024) F.ZC[row * 1536 + n] = (bf16)f2bf(v);
            else if (n < 4608) F.Q[row * DQKV + (n - 3072)] = (bf16)f2bf(v * QSCALE);
            else if (n < 6144) F.KB[row * DQKV + (n - 4608)] = (bf16)f2bf(v);
            else if (n < 7680) F.VB[row * DQKV + (n - 6144)] = (bf16)f2bf(v);
            else F.G_[row * NG + (n - 7680)] = (bf16)f2bf(sigmoidf_(v));
        }
    }
}
__device__ __forceinline__ void nv_za(Frame& F) {
    const int t256 = F.tid & 255;
    NV_LOOP(4, M) {
        const int ch = NV_BX(4) * 256 + t256, t = NV_BY(4), tt = t & (SEQ - 1);
        const float um = tt > 0 ? bf2f(F.U[(size_t)(t - 1) * D + ch]) : 0.f, u0 = bf2f(F.U[(size_t)t * D + ch]), up = tt < SEQ - 1 ? bf2f(F.U[(size_t)(t + 1) * D + ch]) : 0.f;
        const float cv = F.conv_w[ch] * um + F.conv_w[D + ch] * u0 + F.conv_w[2 * D + ch] * up;
        F.ZC[(size_t)t * 1536 + ch] = (bf16)f2bf(bf2f(F.ZC[(size_t)t * 1536 + ch]) * cv);
    }
}
__device__ __forceinline__ void nv_attn(Frame& F) {
    for (int wv = F.vcu * NWAVES + F.wave; wv < M * 8; wv += F.G * NWAVES) {
        const int lane = F.lane, t = wv >> 3, hs = wv & 7, bb = t / SEQ, tt = t - bb * SEQ;
        float m = -1e30f, l = 0.f, o = 0.f;
        for (int g = 0; g < 3; ++g) {
            const int dil = g == 0 ? 1 : g == 1 ? 4 : 16;
            const int col = g * 512 + hs * 64 + lane;
            const float slope2 = exp2f(-8.0f * (float)(g * 8 + hs + 1) / 24.0f) * LOG2E * (float)dil;
            const float q = bf2f(F.Q[(size_t)t * DQKV + col]);
            for (int j = -64; j <= 64; ++j) {
                const int ss = tt + j * dil;
                if (ss < 0 || ss >= SEQ) continue;
                const size_t kr = (size_t)(bb * SEQ + ss) * DQKV + col;
                const float s = wave_sum(q * bf2f(F.KB[kr])) - slope2 * (float)(j < 0 ? -j : j);
                const float mn = fmaxf(m, s), a = exp2f(m - mn), p = exp2f(s - mn);
                l = l * a + p; o = o * a + p * bf2f(F.VB[kr]); m = mn;
            }
        }
        F.ZC[(size_t)t * 1536 + 1024 + hs * 64 + lane] = (bf16)f2bf(o / l);
    }
}
__device__ __forceinline__ void nv_merge(Frame& F) {
    const int t256 = F.tid & 255;
    NV_LOOP(4, M / 8) {
        const int n = NV_BX(4) * 256 + t256, row0 = NV_BY(4) * 8;
        float a1[8], a2[8];
        nv_dot8<1024>(F.ZC + (size_t)row0 * 1536, 1536, F.WAB + (size_t)n * 1536, a1);
        nv_dot8<512>(F.ZC + (size_t)row0 * 1536 + 1024, 1536, F.WAB + (size_t)n * 1536 + 1024, a2);
#pragma unroll
        for (int r = 0; r < 8; ++r) { const size_t row = row0 + r;
            F.MG[row * D + n] = (bf16)f2bf(bf2f(F.G_[row * NG + n]) * a1[r] + bf2f(F.G_[row * NG + 1024 + n]) * a2[r]); }
    }
}
__device__ __forceinline__ void nv_mix(Frame& F) {
    const int t256 = F.tid & 255;
    NV_LOOP(4, M / 8) {
        const int n = NV_BX(4) * 256 + t256, row0 = NV_BY(4) * 8;
        float acc[8]; nv_dot8<D>(F.MG + (size_t)row0 * D, D, F.WO + (size_t)n * D, acc);
#pragma unroll
        for (int r = 0; r < 8; ++r) { const size_t row = row0 + r;
            const float h = (F.x[row * D + n] - F.ST0[2 * row]) * F.ST0[2 * row + 1] * F.ln0_g[n] + F.ln0_b[n];
            F.out[row * D + n] = ALPHA * h + acc[r] + F.b_o[n]; }
    }
}
__device__ __forceinline__ void nv_up(Frame& F) {
    const int t256 = F.tid & 255;
    NV_LOOP(NUP / 256, M / 8) {
        const int n = NV_BX(NUP / 256) * 256 + t256, row0 = NV_BY(NUP / 256) * 8;
        float acc[8]; nv_dot8<D>(F.XN + (size_t)row0 * D, D, F.WUP + (size_t)n * D, acc);
        const float bs = F.BUPP[n]; const int j = n >> 8, w = n & 255;
#pragma unroll
        for (int r = 0; r < 8; ++r) { const size_t row = row0 + r;
            if (w < 128) F.A1[row * DFF + 128 * j + w] = (bf16)f2bf(acc[r] + bs); else F.GT[row * DFF + 128 * j + w - 128] = (bf16)f2bf(acc[r] + bs); }
    }
}
__device__ __forceinline__ void nv_f(Frame& F) {
    const int t256 = F.tid & 255;
    NV_LOOP(DFF / 256, M) {
        const int ch = NV_BX(DFF / 256) * 256 + t256, t = NV_BY(DFF / 256), tt = t & (SEQ - 1);
        const float am = tt > 0 ? bf2f(F.A1[(size_t)(t - 1) * DFF + ch]) : 0.f, a0 = bf2f(F.A1[(size_t)t * DFF + ch]), ap = tt < SEQ - 1 ? bf2f(F.A1[(size_t)(t + 1) * DFF + ch]) : 0.f;
        const float v = F.fcw[ch] * am + F.fcw[DFF + ch] * a0 + F.fcw[2 * DFF + ch] * ap + F.fcb[ch];
        const float ge = 0.5f * v * (1.f + erff(v * 0.70710678118654752f));
        F.GT[(size_t)t * DFF + ch] = (bf16)f2bf(ge * bf2f(F.GT[(size_t)t * DFF + ch]));
    }
}
__device__ __forceinline__ void nv_down(Frame& F) {
    const int t256 = F.tid & 255;
    NV_LOOP(4, M / 8) {
        const int n = NV_BX(4) * 256 + t256, row0 = NV_BY(4) * 8;
        float acc[8]; nv_dot8<DFF>(F.GT + (size_t)row0 * DFF, DFF, F.WDN + (size_t)n * DFF, acc);
#pragma unroll
        for (int r = 0; r < 8; ++r) { const size_t row = row0 + r; F.out[row * D + n] = ALPHA * F.out[row * D + n] + acc[r] + F.b_dn[n]; }
    }
}
__device__ __forceinline__ void ln_phase(Frame& F, const float* g, const float* b, bf16* obf) {
    for (int m = F.vcu * NWAVES + F.wave; m < M; m += F.G * NWAVES) ln_row(F.out + (size_t)m * D, g, b, F.out + (size_t)m * D, obf ? obf + (size_t)m * D : nullptr, nullptr, F.lane);
}

#ifndef NV_P1
#define NV_P1 0
#define NV_P3 0
#define NV_P4 0
#define NV_P5 0
#define NV_P7 0
#define NV_P9 0
#endif
struct Args { const float* in[20]; float* out; unsigned char* ws; int ph_lo, ph_hi; };
constexpr int NPHASE = 11;
__global__ void __launch_bounds__(NTHREADS, 2) mk_fwd(Args args) {
    extern __shared__ __attribute__((aligned(16))) unsigned char lds[];
    Frame F;
    F.lds = (LAS unsigned char*)lds; F.MISC = (volatile LAS unsigned*)(F.lds + MISC_OFF);
    F.tid = threadIdx.x; F.lane = F.tid & 63; F.wave = __builtin_amdgcn_readfirstlane(F.tid >> 6);
    F.G = gridDim.x; { const int bx = blockIdx.x; F.vcu = (F.G % 8 == 0) ? (bx % 8) * (F.G / 8) + bx / 8 : bx; }
    unsigned char* ws = args.ws;
    F.ctl = (gu32*)(ws + WS_CTL);
    F.x = args.in[0]; F.ln0_g = args.in[1]; F.ln0_b = args.in[2]; F.w_in = args.in[3]; F.b_in = args.in[4]; F.conv_w = args.in[5]; F.w_a = args.in[6]; F.w_b = args.in[7];
    F.w_o = args.in[8]; F.b_o = args.in[9]; F.ln1_g = args.in[10]; F.ln1_b = args.in[11]; F.w_up = args.in[12]; F.b_up = args.in[13]; F.fcw = args.in[14]; F.fcb = args.in[15];
    F.w_dn = args.in[16]; F.b_dn = args.in[17]; F.ln2_g = args.in[18]; F.ln2_b = args.in[19]; F.out = args.out;
    F.ST0 = (float*)(ws + WS_ST0); F.BIASP = (float*)(ws + WS_BIASP); F.BUPP = (float*)(ws + WS_BUPP); F.LSE = (float*)(ws + WS_LSE);
    F.WUP = (bf16*)(ws + WS_WUP); F.WDN = (bf16*)(ws + WS_WDN); F.WIN = (bf16*)(ws + WS_WIN); F.WAB = (bf16*)(ws + WS_WAB); F.WO = (bf16*)(ws + WS_WO);
    F.XN = (bf16*)(ws + WS_XN); F.ZC = (bf16*)(ws + WS_ZC); F.U = (bf16*)(ws + WS_U); F.Q = (bf16*)(ws + WS_Q); F.KB = (bf16*)(ws + WS_K); F.VB = (bf16*)args.out;
    F.G_ = (bf16*)(ws + WS_G); F.MG = (bf16*)(ws + WS_MG); F.A1 = (bf16*)(ws + WS_A1); F.GT = (bf16*)(ws + WS_GT);
    for (int u = F.tid; u < (LDS_BYTES - LDSCTL_OFF) / 4; u += NTHREADS) ((LAS unsigned*)(F.lds + LDSCTL_OFF))[u] = 0u;
    __syncthreads();
    XcdBarrier bar = xcd_barrier_post((unsigned*)(F.ctl + CW_BAR), F.MISC + 8);
    const int lo = args.ph_lo, hi = args.ph_hi;
#define IN(k) (lo <= (k) && (k) < hi)
#define SEAM(k) do { if (IN(k) && IN((k) + 1)) xcd_barrier(bar); } while (0)
    if (IN(0)) { p0_prologue(F); } SEAM(0);
    if (IN(1)) {
#if NV_P1
        nv_proj(F, 0, NP1);
#else
        pg8::Gemm g{F.XN, F.WIN, M, NP1, D}; pg8::StaticOrder S; S.init(M, NP1, F.G, (int)blockIdx.x);
        pg8::EpiProj E{F.ZC, F.U, F.Q, F.KB, F.VB, F.BIASP, QSCALE};
        pg8::gemm_phase<pg8::EpiProj, pg8::StaticOrder, true, true>(F.lds + RING_OFF, g, S, E);
#endif
    } SEAM(1);
    if (IN(2)) { nv_attn(F); nv_za(F); } SEAM(2);
    if (IN(3)) {
#if NV_P3
        nv_proj(F, NP1, NG);
#else
        pg8::Gemm g{F.XN, F.WIN + (size_t)NP1 * D, M, NG, D}; pg8::StaticOrder S; S.init(M, NG, F.G, (int)blockIdx.x);
        pg8::EpiSig E{F.G_, F.BIASP + NP1};
        pg8::gemm_phase<pg8::EpiSig, pg8::StaticOrder, true, true>(F.lds + RING_OFF, g, S, E);
#endif
    } SEAM(3);
    if (IN(4)) {
#if NV_P4
        nv_merge(F);
#else
        pg8::Gemm g{F.ZC, F.WAB, M, D, 1536}; pg8::StaticOrder S; S.init(M, D, F.G, (int)blockIdx.x);
        pg8::EpiMerge E{F.G_, F.MG};
        pg8::gemm_phase<pg8::EpiMerge, pg8::StaticOrder, true, true>(F.lds + RING_OFF, g, S, E);
#endif
    } SEAM(4);
    if (IN(5)) {
#if NV_P5
        nv_mix(F);
#else
        pg8::Gemm g{F.MG, F.WO, M, D, D}; pg8::StaticOrder S; S.init(M, D, F.G, (int)blockIdx.x);
        pg8::EpiMix E{F.x, F.ST0, F.ln0_g, F.ln0_b, F.b_o, F.out, ALPHA};
        pg8::gemm_phase<pg8::EpiMix, pg8::StaticOrder, true, true>(F.lds + RING_OFF, g, S, E);
#endif
    } SEAM(5);
    if (IN(6)) { ln_phase(F, F.ln1_g, F.ln1_b, F.XN); } SEAM(6);
    if (IN(7)) {
#if NV_P7
        nv_up(F);
#else
        pg8::Gemm g{F.XN, F.WUP, M, NUP, D}; pg8::StaticOrder S; S.init(M, NUP, F.G, (int)blockIdx.x);
        pg8::EpiUp E{F.A1, F.GT, F.BUPP};
        pg8::gemm_phase<pg8::EpiUp, pg8::StaticOrder, true, true>(F.lds + RING_OFF, g, S, E);
#endif
    } SEAM(7);
    if (IN(8)) { nv_f(F); } SEAM(8);
    if (IN(9)) {
#if NV_P9
        nv_down(F);
#else
        pg8::Gemm g{F.GT, F.WDN, M, D, DFF}; pg8::StaticOrder S; S.init(M, D, F.G, (int)blockIdx.x);
        pg8::EpiDown E{F.out, F.b_dn, ALPHA};
        pg8::gemm_phase<pg8::EpiDown, pg8::StaticOrder, true, true>(F.lds + RING_OFF, g, S, E);
#endif
    } SEAM(9);
    if (IN(10)) { ln_phase(F, F.ln2_g, F.ln2_b, nullptr); }
#undef IN
#undef SEAM
}

extern "C" void kernel_launch(void* const* d_in, const int* in_sizes, int n_in, void* d_out, int out_size, void* d_ws, size_t ws_size, hipStream_t stream) {
    static int grid = 0;
    if (grid == 0) {
        if (n_in != 20 || in_sizes[0] != M * D || out_size != M * D || ws_size < WS_END) { fprintf(stderr, "kernel_launch: unexpected shapes (n_in %d out %d ws %zu); nothing launched\n", n_in, out_size, ws_size); grid = -1; return; }
        int dev = 0, cus = 0, per_cu = 0;
        if (hipGetDevice(&dev) != hipSuccess || hipDeviceGetAttribute(&cus, hipDeviceAttributeMultiprocessorCount, dev) != hipSuccess) { grid = -1; return; }
        if (hipFuncSetAttribute((const void*)mk_fwd, hipFuncAttributeMaxDynamicSharedMemorySize, LDS_BYTES) != hipSuccess) { fprintf(stderr, "kernel_launch: hipFuncSetAttribute failed\n"); grid = -1; return; }
        if (hipOccupancyMaxActiveBlocksPerMultiprocessor(&per_cu, (const void*)mk_fwd, NTHREADS, LDS_BYTES) != hipSuccess || per_cu < 1) { fprintf(stderr, "kernel_launch: occupancy query says %d workgroups per CU\n", per_cu); per_cu = 1; }
        (void)hipGetLastError();
        grid = cus;
    }
    if (grid < 0) return;
    if (hipMemsetAsync((char*)d_ws + WS_CTL, 0, CTL_ZERO_BYTES, stream) != hipSuccess) { fprintf(stderr, "kernel_launch: memset failed\n"); return; }
    Args a{};
    for (int i = 0; i < 20; ++i) a.in[i] = (const float*)d_in[i];
    a.out = (float*)d_out; a.ws = (unsigned char*)d_ws; a.ph_lo = 0; a.ph_hi = NPHASE;
    hipLaunchKernelGGL(mk_fwd, dim3(grid), dim3(NTHREADS), LDS_BYTES, stream, a);
}
```

```cpp
#include <hip/hip_runtime.h>
#include <cstdio>
#include <cstdint>

typedef unsigned short bf16;
typedef unsigned v4u __attribute__((ext_vector_type(4)));
typedef float f32x4 __attribute__((ext_vector_type(4)));

constexpr int BATCH = 2, SEQ = 8192, D = 1024, M = BATCH * SEQ;
constexpr int DQKV = 1536, DFF = 2816, NIN = 9728, NP1 = 7680, NG = 2048, NUP = 2 * DFF;
constexpr int OFF_B = 0, OFF_C = 1024, OFF_H = 2048, OFF_Q = 3072, OFF_K = 4608, OFF_V = 6144, OFF_GA = 7680, OFF_GB = 8704;
constexpr float LN_EPS = 1e-5f;
constexpr float ALPHA = 1.189207115002721f;
constexpr float LOG2E = 1.4426950408889634f;
constexpr float QSCALE = 0.125f * LOG2E;

constexpr size_t MiB = 1u << 20;
constexpr size_t WS_CTL = 0;
constexpr size_t WS_ST0 = 512 * 1024;
constexpr size_t WS_BIASP = 640 * 1024;
constexpr size_t WS_BUPP = 704 * 1024;
constexpr size_t WS_WUP = 1 * MiB;
constexpr size_t WS_WDN = 12 * MiB;
constexpr size_t WS_WIN = 18 * MiB;
constexpr size_t WS_WAB = 37 * MiB;
constexpr size_t WS_WO = 40 * MiB;
constexpr size_t WS_XN = 42 * MiB;
constexpr size_t WS_ZC = 74 * MiB;
constexpr size_t WS_U = 122 * MiB;
constexpr size_t WS_Q = 154 * MiB;
constexpr size_t WS_K = 202 * MiB;
constexpr size_t WS_G = 122 * MiB;
constexpr size_t WS_MG = 202 * MiB;
constexpr size_t WS_A1 = 74 * MiB;
constexpr size_t WS_GT = 162 * MiB;
constexpr size_t WS_LSE = 250 * MiB;
constexpr size_t WS_END = 252 * MiB;

__device__ __forceinline__ float bf2f(bf16 v) { return __uint_as_float((unsigned)v << 16); }
__device__ __forceinline__ unsigned f2bf(float f) { unsigned u = __float_as_uint(f); return (u + 0x7fffu + ((u >> 16) & 1u)) >> 16; }
__device__ __forceinline__ unsigned pk2(float lo, float hi) { return f2bf(lo) | (f2bf(hi) << 16); }

__host__ __device__ __forceinline__ int win_row(int n) {
    if (n >= OFF_C && n < OFF_H) { const int c = n - OFF_C; return 1024 + 256 * (c >> 7) + (c & 127); }
    if (n >= OFF_H && n < OFF_Q) { const int c = n - OFF_H; return 1024 + 256 * (c >> 7) + 128 + (c & 127); }
    return n;
}
__host__ __device__ __forceinline__ int wup_row(int n) {
    if (n < DFF) return 256 * (n >> 7) + (n & 127);
    const int c = n - DFF; return 256 * (c >> 7) + 128 + (c & 127);
}

#define GAS __attribute__((address_space(1)))
#define LAS __attribute__((address_space(3)))
typedef GAS unsigned gu32;
#define RLX_AGENT __ATOMIC_RELAXED, __HIP_MEMORY_SCOPE_AGENT
#define LDS_WAIT() asm volatile("s_waitcnt lgkmcnt(0)" ::: "memory")
#define VM_WAIT() asm volatile("s_waitcnt vmcnt(0)" ::: "memory")

constexpr int NWAVES = 8, NTHREADS = NWAVES * 64;
constexpr size_t CTL_ZERO_BYTES = 256 * 1024;
constexpr int CW_BAR = 4096;
constexpr int RING_OFF = 0, RING_BYTES = 131072;
constexpr int LDSCTL_OFF = RING_BYTES, MISC_OFF = LDSCTL_OFF + 320;
constexpr int LDS_BYTES = 147456;

#define XB_TMO      128
#define XB_XCNT(j)  (256  + 64 * (j))
#define XB_XSUB(j)  (1280 + 64 * (j))
#define XB_XGEN(j)  (2304 + 64 * (j))
#define XB_TOP      3328
#define XB_TOPGEN   3392
#define XCD_BAR_WORDS 3456
#define XB_SPIN_CAP (1u << 18)
__device__ __forceinline__ unsigned xb_ld(unsigned* p)              { return __hip_atomic_load(p, __ATOMIC_RELAXED, __HIP_MEMORY_SCOPE_AGENT); }
__device__ __forceinline__ unsigned xb_add(unsigned* p, unsigned v) { return __hip_atomic_fetch_add(p, v, __ATOMIC_RELAXED, __HIP_MEMORY_SCOPE_AGENT); }
__device__ __forceinline__ unsigned xb_xcc_id() { return (unsigned)__builtin_amdgcn_s_getreg((3 << 11) | 20) & 0xFu; }
#define XB_SPIN(cond, bar) do { unsigned _sp = 0; while (cond) { __builtin_amdgcn_s_sleep(1); \
    if ((++_sp & 255u) == 0u) { if (xb_ld(&(bar)[XB_TMO])) break; if (_sp > XB_SPIN_CAP) { atomicAdd(&(bar)[XB_TMO], 1u); break; } } } } while (0)
struct XcdBarrier { unsigned* bar; unsigned x; volatile LAS unsigned* st; };
__device__ __forceinline__ XcdBarrier xcd_barrier_post(unsigned* bar, volatile LAS unsigned* st) {
    XcdBarrier b; b.bar = bar; b.x = xb_xcc_id(); b.st = st;
    if (threadIdx.x == 0) (void)xb_add(&bar[XB_XCNT(b.x)], 1u);
    return b;
}
__device__ __forceinline__ void xcd_barrier_complete(unsigned* bar, unsigned x, unsigned& nloc, unsigned& nx) {
    const unsigned G = gridDim.x * gridDim.y * gridDim.z;
    unsigned sum, cnt, mine, sp = 0u;
    for (;;) {
        sum = 0u; cnt = 0u; mine = 0u;
#pragma unroll
        for (unsigned j = 0; j < 16; ++j) { const unsigned c = xb_ld(&bar[XB_XCNT(j)]); sum += c; cnt += (c > 0u) ? 1u : 0u; mine = (j == x) ? c : mine; }
        if (sum == G) break;
        __builtin_amdgcn_s_sleep(1);
        if ((++sp & 255u) == 0u) { if (xb_ld(&bar[XB_TMO])) break; if (sp > XB_SPIN_CAP) { atomicAdd(&bar[XB_TMO], 1u); break; } }
    }
    nloc = mine > 0u ? mine : 1u; nx = cnt > 0u ? cnt : 1u;
}
__device__ __forceinline__ void xcd_barrier(const XcdBarrier& b) {
    asm volatile("s_waitcnt vmcnt(0)" ::: "memory");
    __syncthreads();
    if (threadIdx.x == 0) {
        unsigned* bar = b.bar;
        __builtin_amdgcn_s_waitcnt(0);
        unsigned nloc = b.st[0], nx = b.st[1];
        if (nloc == 0u) { xcd_barrier_complete(bar, b.x, nloc, nx); b.st[0] = nloc; b.st[1] = nx; }
        const unsigned old = xb_add(&bar[XB_XSUB(b.x)], 1u);
        const unsigned gen = old / nloc;
        if (old + 1u == (gen + 1u) * nloc) {
            __builtin_amdgcn_fence(__ATOMIC_RELEASE, "agent");
            asm volatile("s_waitcnt vmcnt(0)" ::: "memory");
            const unsigned og = xb_add(&bar[XB_TOP], 1u);
            const unsigned tg = og / nx;
            if (og + 1u == (tg + 1u) * nx) xb_add(&bar[XB_TOPGEN], 1u);
            else XB_SPIN(xb_ld(&bar[XB_TOPGEN]) == tg, bar);
            __builtin_amdgcn_fence(__ATOMIC_ACQUIRE, "agent");
            xb_add(&bar[XB_XGEN(b.x)], 1u);
            asm volatile("s_waitcnt vmcnt(0)" ::: "memory");
        } else {
            XB_SPIN(xb_ld(&bar[XB_XGEN(b.x)]) == gen, bar);
            __builtin_amdgcn_fence(__ATOMIC_ACQUIRE, "agent");
            asm volatile("s_waitcnt vmcnt(0)" ::: "memory");
        }
    }
    __syncthreads();
}

namespace pg8 {
#define PG8_LAS __attribute__((address_space(3)))
typedef unsigned short bf16_t;
typedef short bf16x8 __attribute__((ext_vector_type(8)));
typedef float f32x4 __attribute__((ext_vector_type(4)));
typedef unsigned u32x4 __attribute__((ext_vector_type(4)));
constexpr int BM = 256, BK = 64, HALF = 128, HTB = HALF * BK * 2  , STAGE_BYTES = 8 * HTB, NXCD = 8, WGM = 8;

__host__ __device__ __forceinline__ int lds_byte(int r, int c) { const int st = (r >> 4) * 2 + (c >> 5), rr = r & 15, cc = c & 31, ob = rr * 64 + cc * 2; return st * 1024 + (ob ^ (((ob >> 9) & 1) << 5)); }
__host__ __device__ __forceinline__ void stage_rc(int b, int& R, int& C) { const int st = b / 1024, sb = b % 1024, swz = sb ^ (((sb >> 9) & 1) << 5); R = (st >> 1) * 16 + swz / 64; C = (st & 1) * 32 + (swz % 64) / 2; }
__host__ __device__ __forceinline__ int perm32(int rho) { const int n = rho >> 4, i = rho & 15; return 8 * (i >> 2) + 4 * n + (i & 3); }

struct Unit { int pm, pn; };
struct Gemm { const bf16_t* A; const bf16_t* Bt; int M, N, K; };

struct StaticOrder {
    int nM, nN, nwg, G, c;
    __host__ __device__ void init(int M, int N, int G_, int c_) { nM = M / BM; nN = N / BM; nwg = nM * nN; G = G_; c = c_; }
    __host__ __device__ bool next(int i, Unit& u) const {
        const long L = (long)i * G + c; if (L >= nwg) return false;
        int wgid = (int)L; { const int q = nwg / NXCD, r = nwg % NXCD, xcd = wgid % NXCD, off = wgid / NXCD; wgid = (xcd < r ? xcd * (q + 1) : r * (q + 1) + (xcd - r) * q) + off; }
        const int nig = WGM * nN, gid = wgid / nig, fm = gid * WGM, gsz = (nM - fm) < WGM ? (nM - fm) : WGM;
        u.pm = fm + ((wgid % nig) % gsz); u.pn = (wgid % nig) / gsz; return true;
    }
    __device__ __forceinline__ void a_ready(const Unit&) const {}
    __device__ __forceinline__ void done(const Unit&) const {}
};

typedef float f32x2_cv __attribute__((ext_vector_type(2))); typedef __bf16 bf16x2_cv __attribute__((ext_vector_type(2)));
__device__ __forceinline__ unsigned cvt_pk_bf16(float lo, float hi) { const f32x2_cv v = {lo, hi}; const bf16x2_cv b = __builtin_convertvector(v, bf16x2_cv); return __builtin_bit_cast(unsigned, b); }
typedef float f32x2 __attribute__((ext_vector_type(2)));
__device__ __forceinline__ f32x2 gelu_pk(f32x2 v) {
    const f32x2 av = __builtin_elementwise_abs(v), d = av * 0.2316418882f + 1.0f;
    f32x2 t; t.x = __builtin_amdgcn_rcpf(d.x); t.y = __builtin_amdgcn_rcpf(d.y);
    f32x2 q = t * 0.5307027145f + (-0.7265760135f); q = q * t + 0.7107068705f; q = q * t + (-0.142248368f); q = q * t + 0.127414796f; q = q * t;
    const f32x2 s = (v * v) * (-0.72134752044f);
    f32x2 e; e.x = __builtin_amdgcn_exp2f(s.x); e.y = __builtin_amdgcn_exp2f(s.y);
    const f32x2 m = v * (q * e), r = v - m;
    f32x2 o; o.x = v.x < 0.f ? m.x : r.x; o.y = v.y < 0.f ? m.y : r.y; return o;
}


typedef unsigned u32x2 __attribute__((ext_vector_type(2)));
__device__ __forceinline__ u32x4 pack8(const f32x4 v0, const f32x4 v1) { u32x4 w; w.x = cvt_pk_bf16(v0[0], v0[1]); w.y = cvt_pk_bf16(v0[2], v0[3]); w.z = cvt_pk_bf16(v1[0], v1[1]); w.w = cvt_pk_bf16(v1[2], v1[3]); return w; }
__device__ __forceinline__ float bflo(unsigned w) { return __uint_as_float(w << 16); }
__device__ __forceinline__ float bfhi(unsigned w) { return __uint_as_float(w & 0xffff0000u); }
struct EpiProj {
    static constexpr bool PERM = true, AFTER_DRAIN = false; static constexpr int MIDK = 0;
    bf16_t *ZC, *U, *Q, *K, *V; const float* bias; float qscale;
    __device__ __forceinline__ void operator()(const f32x4 (&acc)[2][2][4][2], const Unit& u, int wr, int wc, int fr, int fq) const {
        const int row0 = u.pm * BM + wr * 64 + fr, cw = wc * 32 + 8 * fq, pn = u.pn;
        f32x4 bv[2][2];
#pragma unroll
        for (int bj = 0; bj < 2; ++bj)
#pragma unroll
            for (int n = 0; n < 2; ++n) bv[bj][n] = *(const f32x4*)(bias + pn * BM + bj * HALF + cw + 4 * n);
        if (pn >= 4 && pn < 12) {
            bf16_t* base = U + (pn - 4) * HALF + cw;
#pragma unroll
            for (int ai = 0; ai < 2; ++ai)
#pragma unroll
                for (int m = 0; m < 4; ++m) { bf16_t* rowp = base + (size_t)(row0 + ai * HALF + m * 16) * 1024;
                    const f32x4 v0 = (acc[ai][0][m][0] + bv[0][0]) * (acc[ai][1][m][0] + bv[1][0]), v1 = (acc[ai][0][m][1] + bv[0][1]) * (acc[ai][1][m][1] + bv[1][1]);
                    *(u32x4*)rowp = pack8(v0, v1); }
            return;
        }
        bf16_t* base; int ldc; float sc = 1.f;
        if (pn < 4) { base = ZC + pn * BM; ldc = 1536; }
        else if (pn < 18) { base = Q + (pn - 12) * BM; ldc = 1536; sc = qscale; }
        else if (pn < 24) { base = K + (pn - 18) * BM; ldc = 1536; }
        else { base = V + (pn - 24) * BM; ldc = 1536; }
        base += cw;
#pragma unroll
        for (int ai = 0; ai < 2; ++ai)
#pragma unroll
            for (int m = 0; m < 4; ++m) { bf16_t* rowp = base + (size_t)(row0 + ai * HALF + m * 16) * ldc;
#pragma unroll
                for (int bj = 0; bj < 2; ++bj) *(u32x4*)(rowp + bj * HALF) = pack8((acc[ai][bj][m][0] + bv[bj][0]) * sc, (acc[ai][bj][m][1] + bv[bj][1]) * sc); }
    }
};
struct EpiSig {
    static constexpr bool PERM = true, AFTER_DRAIN = false; static constexpr int MIDK = 0;
    bf16_t* G; const float* bias;
    __device__ __forceinline__ void operator()(const f32x4 (&acc)[2][2][4][2], const Unit& u, int wr, int wc, int fr, int fq) const {
        const int row0 = u.pm * BM + wr * 64 + fr, col0 = u.pn * BM + wc * 32 + 8 * fq;
        f32x4 bv[2][2];
#pragma unroll
        for (int bj = 0; bj < 2; ++bj)
#pragma unroll
            for (int n = 0; n < 2; ++n) bv[bj][n] = *(const f32x4*)(bias + col0 + bj * HALF + 4 * n);
#pragma unroll
        for (int ai = 0; ai < 2; ++ai)
#pragma unroll
            for (int m = 0; m < 4; ++m) { bf16_t* rowp = G + (size_t)(row0 + ai * HALF + m * 16) * 2048 + col0;
#pragma unroll
                for (int bj = 0; bj < 2; ++bj) { f32x4 v[2];
#pragma unroll
                    for (int n = 0; n < 2; ++n) { const f32x4 x = acc[ai][bj][m][n] + bv[bj][n];
#pragma unroll
                        for (int j = 0; j < 4; ++j) v[n][j] = __builtin_amdgcn_rcpf(1.0f + __builtin_amdgcn_exp2f(x[j] * -1.4426950408889634f)); }
                    *(u32x4*)(rowp + bj * HALF) = pack8(v[0], v[1]); } }
    }
};
struct EpiMerge {
    static constexpr bool PERM = true, AFTER_DRAIN = false; static constexpr int MIDK = 16;
    const bf16_t* G; bf16_t* MG;
    __device__ __forceinline__ void mid(f32x4 (&acc)[2][2][4][2], const Unit& u, int wr, int wc, int fr, int fq) const {
        const char* Gb = (const char*)G;
        asm volatile("" : "+v"(fr), "+v"(fq));
        const unsigned off0 = ((unsigned)(u.pm * BM + wr * 64 + fr) * 2048u + (unsigned)(u.pn * BM + wc * 32 + 8 * fq)) * 2u;
#pragma unroll
        for (int ai = 0; ai < 2; ++ai)
#pragma unroll
            for (int m = 0; m < 4; ++m)
#pragma unroll
                for (int bj = 0; bj < 2; ++bj) { const unsigned off = off0 + (unsigned)((ai * HALF + m * 16) * 2048 + bj * HALF) * 2u;
                    const u32x4 ga = *(const u32x4*)(Gb + off), gb = *(const u32x4*)(Gb + off + 2048u);
#pragma unroll
                    for (int w = 0; w < 4; ++w) { const float r0 = bflo(ga[w]) * __builtin_amdgcn_rcpf(bflo(gb[w])), r1 = bfhi(ga[w]) * __builtin_amdgcn_rcpf(bfhi(gb[w]));
                        acc[ai][bj][m][w >> 1][(w & 1) * 2] *= r0; acc[ai][bj][m][w >> 1][(w & 1) * 2 + 1] *= r1; }
                    asm volatile("" ::: "memory"); }
    }
    __device__ __forceinline__ void operator()(const f32x4 (&acc)[2][2][4][2], const Unit& u, int wr, int wc, int fr, int fq) const {
        asm volatile("" : "+v"(fr), "+v"(fq));
        const int row0 = u.pm * BM + wr * 64 + fr, col0 = u.pn * BM + wc * 32 + 8 * fq;
#pragma unroll
        for (int ai = 0; ai < 2; ++ai)
#pragma unroll
            for (int m = 0; m < 4; ++m) { const size_t ro = (size_t)(row0 + ai * HALF + m * 16);
#pragma unroll
                for (int bj = 0; bj < 2; ++bj) { const u32x4 gb = *(const u32x4*)(G + ro * 2048 + 1024 + col0 + bj * HALF);
                    const f32x4 g0 = {bflo(gb[0]), bfhi(gb[0]), bflo(gb[1]), bfhi(gb[1])}, g1 = {bflo(gb[2]), bfhi(gb[2]), bflo(gb[3]), bfhi(gb[3])};
                    *(u32x4*)(MG + ro * 1024 + col0 + bj * HALF) = pack8(acc[ai][bj][m][0] * g0, acc[ai][bj][m][1] * g1); } }
    }
};
struct EpiMix {
    static constexpr bool PERM = false, AFTER_DRAIN = false; static constexpr int MIDK = 0;
    const float *x, *st, *g0, *b0, *bo; float* R1; float alpha;
    __device__ __forceinline__ void operator()(const f32x4 (&acc)[2][2][4][2], const Unit& u, int wr, int wc, int fr, int fq) const {
        const int row0 = u.pm * BM + wr * 64 + fr, col0 = u.pn * BM + wc * 32 + 4 * fq;
        f32x4 gv[2][2], bv[2][2];
#pragma unroll
        for (int bj = 0; bj < 2; ++bj)
#pragma unroll
            for (int n = 0; n < 2; ++n) { const int c = col0 + bj * HALF + n * 16; gv[bj][n] = *(const f32x4*)(g0 + c) * alpha; bv[bj][n] = *(const f32x4*)(b0 + c) * alpha + *(const f32x4*)(bo + c); }
#pragma unroll
        for (int ai = 0; ai < 2; ++ai)
#pragma unroll
            for (int m = 0; m < 4; ++m) { const size_t ro = (size_t)(row0 + ai * HALF + m * 16); const float mean = st[2 * ro], rstd = st[2 * ro + 1];
#pragma unroll
                for (int bj = 0; bj < 2; ++bj)
#pragma unroll
                    for (int n = 0; n < 2; ++n) { const size_t off = ro * 1024 + col0 + bj * HALF + n * 16; const f32x4 xv = *(const f32x4*)(x + off);
                        *(f32x4*)(R1 + off) = (xv - mean) * rstd * gv[bj][n] + bv[bj][n] + acc[ai][bj][m][n]; } }
    }
};
struct EpiUp {
    static constexpr bool PERM = true, AFTER_DRAIN = false; static constexpr int MIDK = 0;
    bf16_t *A1, *GT; const float* bias;
    __device__ __forceinline__ void operator()(const f32x4 (&acc)[2][2][4][2], const Unit& u, int wr, int wc, int fr, int fq) const {
        const int row0 = u.pm * BM + wr * 64 + fr, cw = wc * 32 + 8 * fq, ch0 = u.pn * HALF + cw;
        f32x4 bv[2][2];
#pragma unroll
        for (int bj = 0; bj < 2; ++bj)
#pragma unroll
            for (int n = 0; n < 2; ++n) bv[bj][n] = *(const f32x4*)(bias + u.pn * BM + bj * HALF + cw + 4 * n);
#pragma unroll
        for (int ai = 0; ai < 2; ++ai)
#pragma unroll
            for (int m = 0; m < 4; ++m) { const size_t ro = (size_t)(row0 + ai * HALF + m * 16) * 2816 + ch0;
                *(u32x4*)(A1 + ro) = pack8(acc[ai][0][m][0] + bv[0][0], acc[ai][0][m][1] + bv[0][1]);
                *(u32x4*)(GT + ro) = pack8(acc[ai][1][m][0] + bv[1][0], acc[ai][1][m][1] + bv[1][1]); }
    }
};
struct EpiDown {
    static constexpr bool PERM = false, AFTER_DRAIN = false; static constexpr int MIDK = 0;
    float* H; const float* bd; float alpha;
    __device__ __forceinline__ void operator()(const f32x4 (&acc)[2][2][4][2], const Unit& u, int wr, int wc, int fr, int fq) const {
        const int row0 = u.pm * BM + wr * 64 + fr, col0 = u.pn * BM + wc * 32 + 4 * fq;
        f32x4 bv[2][2];
#pragma unroll
        for (int bj = 0; bj < 2; ++bj)
#pragma unroll
            for (int n = 0; n < 2; ++n) bv[bj][n] = *(const f32x4*)(bd + col0 + bj * HALF + n * 16);
#pragma unroll
        for (int ai = 0; ai < 2; ++ai)
#pragma unroll
            for (int m = 0; m < 4; ++m) { const size_t ro = (size_t)(row0 + ai * HALF + m * 16) * 1024 + col0;
#pragma unroll
                for (int bj = 0; bj < 2; ++bj)
#pragma unroll
                    for (int n = 0; n < 2; ++n) { float* p = H + ro + bj * HALF + n * 16; *(f32x4*)p = *(const f32x4*)p * alpha + acc[ai][bj][m][n] + bv[bj][n]; } }
    }
};

template <class Epi, class Sched, bool ALIGN_EPI = false, bool SP2 = false>
__device__ __forceinline__ void gemm_phase(PG8_LAS unsigned char* lds, const Gemm g, const Sched& S, const Epi& E) {
    const int tid = threadIdx.x, wid = __builtin_amdgcn_readfirstlane(tid >> 6), lane = tid & 63, wr = wid >> 2, wc = wid & 3, fr = lane & 15, fq = lane >> 4;
    const int K = g.K, nt = K / BK;
    unsigned voffA[2], voffB[2];
#pragma unroll
    for (int i = 0; i < 2; ++i) { int R, C; stage_rc(tid * 16 + i * 8192, R, C); const int Rb = Epi::PERM ? ((R & ~31) + perm32(R & 31)) : R;
        voffA[i] = (unsigned)(R * K + C) * 2u; voffB[i] = (unsigned)(Rb * K + C) * 2u; }
    const size_t kstep = (size_t)(BK * 2);
    const size_t hstep = (size_t)HALF * K * 2;
    const size_t tstep = 2 * hstep;
    const unsigned ldsw = (unsigned)wid * 1024u;
    const int aoff = lds_byte(wr * 64 + fr, fq * 8), boff = lds_byte(wc * 32 + fr, fq * 8);
#define PG8_SA(b, h) (((b) * 2 + (h)) * HTB)
#define PG8_SB(b, h) ((4 + (b) * 2 + (h)) * HTB)
#define PG8_STAGE(bufoff, gbase, voff) do { _Pragma("unroll") for (int _i = 0; _i < 2; ++_i) \
        __builtin_amdgcn_global_load_lds((const unsigned*)((const char*)(gbase) + (voff)[_i]), (PG8_LAS unsigned*)(lds + (bufoff) + ldsw + _i * 8192), 16, 0, 0); } while (0)
#define PG8_LDA(dst, b, h) do { _Pragma("unroll") for (int m = 0; m < 4; ++m) _Pragma("unroll") for (int k = 0; k < 2; ++k) dst[m][k] = *(const PG8_LAS bf16x8*)(lds + PG8_SA(b, h) + aoff + m * 2048 + k * 1024); } while (0)
#define PG8_LDB(dst, b, h) do { _Pragma("unroll") for (int n = 0; n < 2; ++n) _Pragma("unroll") for (int k = 0; k < 2; ++k) dst[n][k] = *(const PG8_LAS bf16x8*)(lds + PG8_SB(b, h) + boff + n * 2048 + k * 1024); } while (0)
#define PG8_MMA(ai, bj, At, Bt) do { __builtin_amdgcn_s_setprio(1); _Pragma("unroll") for (int m = 0; m < 4; ++m) _Pragma("unroll") for (int n = 0; n < 2; ++n) _Pragma("unroll") for (int k = 0; k < 2; ++k) \
        acc[ai][bj][m][n] = __builtin_amdgcn_mfma_f32_16x16x32_bf16(Bt[n][k], At[m][k], acc[ai][bj][m][n], 0, 0, 0); __builtin_amdgcn_s_setprio(0); } while (0)
#define PG8_WAIT_V(n) asm volatile("s_waitcnt vmcnt(" #n ")" ::: "memory")
#define PG8_WAIT_L(n) asm volatile("s_waitcnt lgkmcnt(" #n ")" ::: "memory")
#define PG8_BAR __builtin_amdgcn_s_barrier()
#define PG8_SCHED __builtin_amdgcn_sched_barrier(0)
    Unit cur, nxt; int ui = 0;
    if (!S.next(0, cur)) return;
    f32x4 acc[2][2][4][2];
#pragma unroll
    for (int a = 0; a < 2; ++a)
#pragma unroll
        for (int b = 0; b < 2; ++b)
#pragma unroll
            for (int m = 0; m < 4; ++m)
#pragma unroll
                for (int n = 0; n < 2; ++n) acc[a][b][m][n] = (f32x4){0.f, 0.f, 0.f, 0.f};
    bf16x8 At[4][2], B0[2][2], B1[2][2];
    const char* cA = (const char*)g.A + (size_t)cur.pm * tstep; const char* cB = (const char*)g.Bt + (size_t)cur.pn * tstep;
    S.a_ready(cur);
    if constexpr (SP2) {
        PG8_STAGE(PG8_SB(0, 0), cB, voffB); PG8_STAGE(PG8_SB(0, 1), cB + hstep, voffB); PG8_STAGE(PG8_SA(0, 0), cA, voffA); PG8_STAGE(PG8_SA(0, 1), cA + hstep, voffA);
        if (wr == 1) PG8_BAR;
        PG8_WAIT_V(2); PG8_BAR;
        PG8_STAGE(PG8_SB(1, 0), cB + kstep, voffB); PG8_STAGE(PG8_SA(1, 0), cA + kstep, voffA); PG8_STAGE(PG8_SB(1, 1), cB + hstep + kstep, voffB);
        PG8_WAIT_V(6); PG8_BAR;
    } else {
        PG8_STAGE(PG8_SB(0, 0), cB, voffB); PG8_STAGE(PG8_SA(0, 0), cA, voffA); PG8_STAGE(PG8_SB(0, 1), cB + hstep, voffB); PG8_STAGE(PG8_SA(0, 1), cA + hstep, voffA);
        if (wr == 1) PG8_BAR;
        PG8_WAIT_V(4); PG8_BAR;
        PG8_STAGE(PG8_SB(1, 0), cB + kstep, voffB); PG8_STAGE(PG8_SA(1, 0), cA + kstep, voffA); PG8_STAGE(PG8_SB(1, 1), cB + hstep + kstep, voffB);
        PG8_WAIT_V(6); PG8_BAR;
    }
    for (;;) {
        const bool has_next = S.next(ui + 1, nxt);
        const char* nA = has_next ? (const char*)g.A + (size_t)nxt.pm * tstep : cA; const char* nB = has_next ? (const char*)g.Bt + (size_t)nxt.pn * tstep : cB;
        constexpr int NSEG = Epi::MIDK > 0 ? 2 : 1;
        for (int seg = 0; seg < NSEG; ++seg) {
        const int tb = (seg == 0) ? 0 : Epi::MIDK, te = (NSEG == 2 && seg == 0) ? Epi::MIDK : nt;
        for (int t = tb; t < te; t += 2) {
            const bool last = (t == nt - 2);
            const char* a1 = cA + (size_t)(t + 1) * kstep;
            const char* a2 = last ? nA : cA + (size_t)(t + 2) * kstep; const char* b2 = last ? nB : cB + (size_t)(t + 2) * kstep;
            const char* a3 = a2 + kstep; const char* b3 = b2 + kstep;
            if (last && has_next) S.a_ready(nxt);
            if constexpr (SP2) {
            PG8_LDB(B0, 0, 0); PG8_LDB(B1, 0, 1); PG8_SCHED; PG8_LDA(At, 0, 0); PG8_STAGE(PG8_SA(1, 1), a1 + hstep, voffA);
            PG8_WAIT_V(8); PG8_WAIT_L(0); PG8_BAR; PG8_MMA(0, 0, At, B0); PG8_MMA(0, 1, At, B1); PG8_BAR; PG8_SCHED;
            PG8_LDA(At, 0, 1); PG8_STAGE(PG8_SB(0, 0), b2, voffB); PG8_STAGE(PG8_SB(0, 1), b2 + hstep, voffB); PG8_STAGE(PG8_SA(0, 0), a2, voffA);
            PG8_WAIT_V(8); PG8_WAIT_L(0); PG8_BAR; PG8_MMA(1, 0, At, B0); PG8_MMA(1, 1, At, B1); PG8_BAR; PG8_SCHED;
            PG8_LDB(B0, 1, 0); PG8_LDB(B1, 1, 1); PG8_SCHED; PG8_LDA(At, 1, 0); PG8_STAGE(PG8_SA(0, 1), a2 + hstep, voffA);
            PG8_WAIT_V(8); PG8_WAIT_L(0); PG8_BAR; PG8_MMA(0, 0, At, B0); PG8_MMA(0, 1, At, B1); PG8_BAR; PG8_SCHED;
            PG8_LDA(At, 1, 1); PG8_STAGE(PG8_SB(1, 0), b3, voffB); PG8_STAGE(PG8_SB(1, 1), b3 + hstep, voffB); PG8_STAGE(PG8_SA(1, 0), a3, voffA);
            PG8_WAIT_V(8); PG8_WAIT_L(0); PG8_BAR; PG8_MMA(1, 0, At, B0); PG8_MMA(1, 1, At, B1); PG8_BAR; PG8_SCHED;
            } else {
            PG8_LDB(B0, 0, 0); PG8_SCHED; PG8_LDA(At, 0, 0); PG8_STAGE(PG8_SA(1, 1), a1 + hstep, voffA);
            PG8_WAIT_L(8); PG8_BAR; PG8_WAIT_L(0); PG8_MMA(0, 0, At, B0); PG8_BAR; PG8_SCHED;
            PG8_LDB(B1, 0, 1); PG8_STAGE(PG8_SB(0, 0), b2, voffB);
            PG8_BAR; PG8_WAIT_L(0); PG8_MMA(0, 1, At, B1); PG8_BAR;
            PG8_LDA(At, 0, 1); PG8_STAGE(PG8_SA(0, 0), a2, voffA);
            PG8_BAR; PG8_WAIT_L(0); PG8_MMA(1, 0, At, B0); PG8_BAR; PG8_SCHED;
            PG8_STAGE(PG8_SB(0, 1), b2 + hstep, voffB);
            PG8_WAIT_V(6); PG8_BAR; PG8_MMA(1, 1, At, B1); PG8_BAR;
            PG8_LDB(B0, 1, 0); PG8_SCHED; PG8_LDA(At, 1, 0); PG8_STAGE(PG8_SA(0, 1), a2 + hstep, voffA);
            PG8_WAIT_L(8); PG8_BAR; PG8_WAIT_L(0); PG8_MMA(0, 0, At, B0); PG8_BAR; PG8_SCHED;
            PG8_LDB(B1, 1, 1); PG8_STAGE(PG8_SB(1, 0), b3, voffB);
            PG8_BAR; PG8_WAIT_L(0); PG8_MMA(0, 1, At, B1); PG8_BAR;
            PG8_LDA(At, 1, 1); PG8_STAGE(PG8_SA(1, 0), a3, voffA);
            PG8_BAR; PG8_WAIT_L(0); PG8_MMA(1, 0, At, B0); PG8_BAR; PG8_SCHED;
            PG8_STAGE(PG8_SB(1, 1), b3 + hstep, voffB);
            PG8_WAIT_V(6); PG8_BAR; PG8_MMA(1, 1, At, B1); PG8_BAR;
            }
        }
        if constexpr (Epi::MIDK > 0) { if (seg == 0) E.mid(acc, cur, wr, wc, fr, fq); }
        }
        if constexpr (ALIGN_EPI) { if (wr == 0) PG8_BAR; }
        if constexpr (!Epi::AFTER_DRAIN) { E(acc, cur, wr, wc, fr, fq); S.done(cur); }
        if (!has_next) break;
#pragma unroll
        for (int a = 0; a < 2; ++a)
#pragma unroll
            for (int b = 0; b < 2; ++b)
#pragma unroll
                for (int m = 0; m < 4; ++m)
#pragma unroll
                    for (int n = 0; n < 2; ++n) acc[a][b][m][n] = (f32x4){0.f, 0.f, 0.f, 0.f};
        cur = nxt; cA = nA; cB = nB; ++ui;
        if constexpr (ALIGN_EPI) { if (wr == 1) PG8_BAR; }
    }
    PG8_WAIT_V(0);
    if constexpr (!ALIGN_EPI) { if (wr == 0) PG8_BAR; }
    PG8_BAR;
    if constexpr (Epi::AFTER_DRAIN) { E.fused(acc, cur, wr, wc, fr, fq, lds, wid, lane); S.done(cur); }
#undef PG8_SA
#undef PG8_SB
#undef PG8_STAGE
#undef PG8_LDA
#undef PG8_LDB
#undef PG8_MMA
#undef PG8_WAIT_V
#undef PG8_WAIT_L
#undef PG8_BAR
#undef PG8_SCHED
}
}

struct Frame {
    LAS unsigned char* lds; volatile LAS unsigned* MISC; gu32* ctl;
    int tid, lane, wave, vcu, G;
    const float *x, *ln0_g, *ln0_b, *w_in, *b_in, *conv_w, *w_a, *w_b, *w_o, *b_o, *ln1_g, *ln1_b, *w_up, *b_up, *fcw, *fcb, *w_dn, *b_dn, *ln2_g, *ln2_b;
    float* out; float *ST0, *BIASP, *BUPP, *LSE;
    bf16 *WUP, *WDN, *WIN, *WAB, *WO, *XN, *ZC, *U, *Q, *KB, *VB, *G_, *MG, *A1, *GT;
};
__device__ __forceinline__ float wave_sum(float v) {
#pragma unroll
    for (int o = 1; o < 64; o <<= 1) v += __shfl_xor(v, o);
    return v;
}
__device__ __forceinline__ void p0_transpose_item(const float* W, int K, int N, bf16* WT, int ldk, int koff, int mode, LAS float* scr, int item, int lane) {
    const int nblk = N / 32, kb = item / nblk, nb = item % nblk, k0 = 64 * kb, n0 = 32 * nb;
    const int r0 = mode == 1 ? win_row(n0) : mode == 2 ? wup_row(n0) : n0;
#pragma unroll 8
    for (int i = 0; i < 32; ++i) { const int kk = 2 * i + (lane >> 5); scr[kk * 33 + (lane & 31)] = W[(size_t)(k0 + kk) * N + n0 + (lane & 31)]; }
    LDS_WAIT(); asm volatile("" ::: "memory");
    const int c = lane & 7;
#pragma unroll
    for (int j = 0; j < 4; ++j) { const int n = (lane >> 3) + 8 * j; const LAS float* s = scr + (8 * c) * 33 + n;
        v4u o; o.x = pk2(s[0 * 33], s[1 * 33]); o.y = pk2(s[2 * 33], s[3 * 33]); o.z = pk2(s[4 * 33], s[5 * 33]); o.w = pk2(s[6 * 33], s[7 * 33]);
        *(GAS v4u*)(WT + (size_t)(r0 + n) * ldk + koff + k0 + 8 * c) = o; }
    LDS_WAIT(); asm volatile("" ::: "memory");
}
__device__ __forceinline__ void ln_row(const float* xrow, const float* g, const float* b, float* of32, bf16* obf, float* st, int lane) {
    const GAS f32x4* xr = (const GAS f32x4*)xrow + lane;
    f32x4 v[4]; float s = 0.f;
#pragma unroll
    for (int j = 0; j < 4; ++j) { v[j] = xr[64 * j]; s += (v[j].x + v[j].y) + (v[j].z + v[j].w); }
    const float mean = wave_sum(s) * (1.f / D); float s2 = 0.f;
#pragma unroll
    for (int j = 0; j < 4; ++j) { v[j] = v[j] - mean; s2 += (v[j].x * v[j].x + v[j].y * v[j].y) + (v[j].z * v[j].z + v[j].w * v[j].w); }
    const float rstd = 1.f / sqrtf(wave_sum(s2) * (1.f / D) + LN_EPS);
    if (st && lane == 0) { st[0] = mean; st[1] = rstd; }
#pragma unroll
    for (int j = 0; j < 4; ++j) {
        const f32x4 gg = ((const GAS f32x4*)g)[lane + 64 * j], bb = ((const GAS f32x4*)b)[lane + 64 * j];
        const f32x4 y = v[j] * rstd * gg + bb;
        if (of32) ((GAS f32x4*)of32)[lane + 64 * j] = y;
        if (obf) ((GAS unsigned long long*)obf)[lane + 64 * j] = (unsigned long long)pk2(y.x, y.y) | ((unsigned long long)pk2(y.z, y.w) << 32);
    }
}
__device__ __forceinline__ void p0_prologue(Frame& F) {
    LAS float* scr = (LAS float*)(F.lds + RING_OFF + F.wave * 16384);
    const int gw = F.vcu * NWAVES + F.wave, NGW = F.G * NWAVES;
    constexpr int I_IN = (D / 64) * (NIN / 32), I_A = (D / 64) * (D / 32), I_B = (512 / 64) * (D / 32), I_O = I_A, I_UP = (D / 64) * (NUP / 32), I_DN = (DFF / 64) * (D / 32);
    constexpr int NITEMS = I_IN + I_A + I_B + I_O + I_UP + I_DN;
    for (int it = gw; it < NITEMS; it += NGW) {
        int r = it;
        if (r < I_IN) { p0_transpose_item(F.w_in, D, NIN, F.WIN, D, 0, 1, scr, r, F.lane); continue; } r -= I_IN;
        if (r < I_A) { p0_transpose_item(F.w_a, D, D, F.WAB, 1536, 0, 0, scr, r, F.lane); continue; } r -= I_A;
        if (r < I_B) { p0_transpose_item(F.w_b, 512, D, F.WAB, 1536, 1024, 0, scr, r, F.lane); continue; } r -= I_B;
        if (r < I_O) { p0_transpose_item(F.w_o, D, D, F.WO, D, 0, 0, scr, r, F.lane); continue; } r -= I_O;
        if (r < I_UP) { p0_transpose_item(F.w_up, D, NUP, F.WUP, D, 0, 2, scr, r, F.lane); continue; } r -= I_UP;
        p0_transpose_item(F.w_dn, DFF, D, F.WDN, DFF, 0, 0, scr, r, F.lane);
    }
    for (int i = F.vcu * NTHREADS + F.tid; i < NIN; i += F.G * NTHREADS) { F.BIASP[win_row(i)] = F.b_in[i]; if (i < NUP) F.BUPP[wup_row(i)] = F.b_up[i]; }
    for (int m = gw; m < M; m += NGW) ln_row(F.x + (size_t)m * D, F.ln0_g, F.ln0_b, nullptr, F.XN + (size_t)m * D, F.ST0 + 2 * m, F.lane);
}

template <int K>
__device__ __forceinline__ void nv_dot8(const bf16* __restrict__ A, int lda, const bf16* __restrict__ Brow, float (&acc)[8]) {
#pragma unroll
    for (int r = 0; r < 8; ++r) acc[r] = 0.f;
    for (int k = 0; k < K; k += 8) {
        const v4u bv = *(const v4u*)(Brow + k);
        float bfv[8];
#pragma unroll
        for (int j = 0; j < 4; ++j) { bfv[2 * j] = __uint_as_float(bv[j] << 16); bfv[2 * j + 1] = __uint_as_float(bv[j] & 0xffff0000u); }
#pragma unroll
        for (int r = 0; r < 8; ++r) {
            const v4u av = *(const v4u*)(A + (size_t)r * lda + k);
#pragma unroll
            for (int j = 0; j < 4; ++j) { acc[r] += __uint_as_float(av[j] << 16) * bfv[2 * j]; acc[r] += __uint_as_float(av[j] & 0xffff0000u) * bfv[2 * j + 1]; }
        }
    }
}
__device__ __forceinline__ float sigmoidf_(float v) { return 1.f / (1.f + __expf(-v)); }
#define NV_LOOP(nbx, nby) for (int vb_ = 2 * (int)blockIdx.x + (F.tid >> 8); vb_ < (nbx) * (nby); vb_ += 2 * F.G)
#define NV_BX(nbx) (vb_ % (nbx))
#define NV_BY(nbx) (vb_ / (nbx))
__device__ __forceinline__ void nv_proj(Frame& F, int n_off, int ncols) {
    const int t256 = F.tid & 255, nbx = ncols / 256;
    NV_LOOP(nbx, M / 8) {
        const int n = n_off + NV_BX(nbx) * 256 + t256, row0 = NV_BY(nbx) * 8;
        if (n >= 1024 && n < 3072) {
            if (t256 < 128) {
                float ac[8], ah[8]; nv_dot8<D>(F.XN + (size_t)row0 * D, D, F.WIN + (size_t)n * D, ac); nv_dot8<D>(F.XN + (size_t)row0 * D, D, F.WIN + (size_t)(n + 128) * D, ah);
                const float bc = F.BIASP[n], bh = F.BIASP[n + 128]; const int ch = 128 * ((n - 1024) >> 8) + t256;
#pragma unroll
                for (int r = 0; r < 8; ++r) F.U[(size_t)(row0 + r) * D + ch] = (bf16)f2bf((ac[r] + bc) * (ah[r] + bh));
            }
            continue;
        }
        float acc[8]; nv_dot8<D>(F.XN + (size_t)row0 * D, D, F.WIN + (size_t)n * D, acc);
        const float bs = F.BIASP[n];
#pragma unroll
        for (int r = 0; r < 8; ++r) {
            const float v = acc[r] + bs; const size_t row = row0 + r;
            if (n < 1024) F.ZC[row * 1536 + n] = (bf16)f2bf(v);
            else if (n < 4608) F.Q[row * DQKV + (n - 3072)] = (bf16)f2bf(v * QSCALE);
            else if (n < 6144) F.KB[row * DQKV + (n - 4608)] = (bf16)f2bf(v);
            else if (n < 7680) F.VB[row * DQKV + (n - 6144)] = (bf16)f2bf(v);
            else F.G_[row * NG + (n - 7680)] = (bf16)f2bf(sigmoidf_(v));
        }
    }
}
__device__ __forceinline__ void nv_za(Frame& F) {
    const int t256 = F.tid & 255;
    NV_LOOP(4, M) {
        const int ch = NV_BX(4) * 256 + t256, t = NV_BY(4), tt = t & (SEQ - 1);
        const float um = tt > 0 ? bf2f(F.U[(size_t)(t - 1) * D + ch]) : 0.f, u0 = bf2f(F.U[(size_t)t * D + ch]), up = tt < SEQ - 1 ? bf2f(F.U[(size_t)(t + 1) * D + ch]) : 0.f;
        const float cv = F.conv_w[ch] * um + F.conv_w[D + ch] * u0 + F.conv_w[2 * D + ch] * up;
        F.ZC[(size_t)t * 1536 + ch] = (bf16)f2bf(bf2f(F.ZC[(size_t)t * 1536 + ch]) * cv);
    }
}
__device__ __forceinline__ void nv_attn(Frame& F) {
    for (int wv = F.vcu * NWAVES + F.wave; wv < M * 8; wv += F.G * NWAVES) {
        const int lane = F.lane, t = wv >> 3, hs = wv & 7, bb = t / SEQ, tt = t - bb * SEQ;
        float m = -1e30f, l = 0.f, o = 0.f;
        for (int g = 0; g < 3; ++g) {
            const int dil = g == 0 ? 1 : g == 1 ? 4 : 16;
            const int col = g * 512 + hs * 64 + lane;
            const float slope2 = exp2f(-8.0f * (float)(g * 8 + hs + 1) / 24.0f) * LOG2E * (float)dil;
            const float q = bf2f(F.Q[(size_t)t * DQKV + col]);
            for (int j = -64; j <= 64; ++j) {
                const int ss = tt + j * dil;
                if (ss < 0 || ss >= SEQ) continue;
                const size_t kr = (size_t)(bb * SEQ + ss) * DQKV + col;
                const float s = wave_sum(q * bf2f(F.KB[kr])) - slope2 * (float)(j < 0 ? -j : j);
                const float mn = fmaxf(m, s), a = exp2f(m - mn), p = exp2f(s - mn);
                l = l * a + p; o = o * a + p * bf2f(F.VB[kr]); m = mn;
            }
        }
        F.ZC[(size_t)t * 1536 + 1024 + hs * 64 + lane] = (bf16)f2bf(o / l);
    }
}
__device__ __forceinline__ void nv_merge(Frame& F) {
    const int t256 = F.tid & 255;
    NV_LOOP(4, M / 8) {
        const int n = NV_BX(4) * 256 + t256, row0 = NV_BY(4) * 8;
        float a1[8], a2[8];
        nv_dot8<1024>(F.ZC + (size_t)row0 * 1536, 1536, F.WAB + (size_t)n * 1536, a1);
        nv_dot8<512>(F.ZC + (size_t)row0 * 1536 + 1024, 1536, F.WAB + (size_t)n * 1536 + 1024, a2);
#pragma unroll
        for (int r = 0; r < 8; ++r) { const size_t row = row0 + r;
            F.MG[row * D + n] = (bf16)f2bf(bf2f(F.G_[row * NG + n]) * a1[r] + bf2f(F.G_[row * NG + 1024 + n]) * a2[r]); }
    }
}
__device__ __forceinline__ void nv_mix(Frame& F) {
    const int t256 = F.tid & 255;
    NV_LOOP(4, M / 8) {
        const int n = NV_BX(4) * 256 + t256, row0 = NV_BY(4) * 8;
        float acc[8]; nv_dot8<D>(F.MG + (size_t)row0 * D, D, F.WO + (size_t)n * D, acc);
#pragma unroll
        for (int r = 0; r < 8; ++r) { const size_t row = row0 + r;
            const float h = (F.x[row * D + n] - F.ST0[2 * row]) * F.ST0[2 * row + 1] * F.ln0_g[n] + F.ln0_b[n];
            F.out[row * D + n] = ALPHA * h + acc[r] + F.b_o[n]; }
    }
}
__device__ __forceinline__ void nv_up(Frame& F) {
    const int t256 = F.tid & 255;
    NV_LOOP(NUP / 256, M / 8) {
        const int n = NV_BX(NUP / 256) * 256 + t256, row0 = NV_BY(NUP / 256) * 8;
        float acc[8]; nv_dot8<D>(F.XN + (size_t)row0 * D, D, F.WUP + (size_t)n * D, acc);
        const float bs = F.BUPP[n]; const int j = n >> 8, w = n & 255;
#pragma unroll
        for (int r = 0; r < 8; ++r) { const size_t row = row0 + r;
            if (w < 128) F.A1[row * DFF + 128 * j + w] = (bf16)f2bf(acc[r] + bs); else F.GT[row * DFF + 128 * j + w - 128] = (bf16)f2bf(acc[r] + bs); }
    }
}
__device__ __forceinline__ void nv_f(Frame& F) {
    const int t256 = F.tid & 255;
    NV_LOOP(DFF / 256, M) {
        const int ch = NV_BX(DFF / 256) * 256 + t256, t = NV_BY(DFF / 256), tt = t & (SEQ - 1);
        const float am = tt > 0 ? bf2f(F.A1[(size_t)(t - 1) * DFF + ch]) : 0.f, a0 = bf2f(F.A1[(size_t)t * DFF + ch]), ap = tt < SEQ - 1 ? bf2f(F.A1[(size_t)(t + 1) * DFF + ch]) : 0.f;
        const float v = F.fcw[ch] * am + F.fcw[DFF + ch] * a0 + F.fcw[2 * DFF + ch] * ap + F.fcb[ch];
        const float ge = 0.5f * v * (1.f + erff(v * 0.70710678118654752f));
        F.GT[(size_t)t * DFF + ch] = (bf16)f2bf(ge * bf2f(F.GT[(size_t)t * DFF + ch]));
    }
}
__device__ __forceinline__ void nv_down(Frame& F) {
    const int t256 = F.tid & 255;
    NV_LOOP(4, M / 8) {
        const int n = NV_BX(4) * 256 + t256, row0 = NV_BY(4) * 8;
        float acc[8]; nv_dot8<DFF>(F.GT + (size_t)row0 * DFF, DFF, F.WDN + (size_t)n * DFF, acc);
#pragma unroll
        for (int r = 0; r < 8; ++r) { const size_t row = row0 + r; F.out[row * D + n] = ALPHA * F.out[row * D + n] + acc[r] + F.b_dn[n]; }
    }
}
__device__ __forceinline__ void ln_phase(Frame& F, const float* g, const float* b, bf16* obf) {
    for (int m = F.vcu * NWAVES + F.wave; m < M; m += F.G * NWAVES) ln_row(F.out + (size_t)m * D, g, b, F.out + (size_t)m * D, obf ? obf + (size_t)m * D : nullptr, nullptr, F.lane);
}

namespace att {
typedef short bf16x8 __attribute__((ext_vector_type(8)));
typedef short s16x4 __attribute__((ext_vector_type(4)));
typedef float f32x16 __attribute__((ext_vector_type(16)));
typedef float f32x2_cv __attribute__((ext_vector_type(2))); typedef __bf16 bf16x2_cv __attribute__((ext_vector_type(2)));
__device__ __forceinline__ unsigned cvtpk(float lo, float hi) { const f32x2_cv v = {lo, hi}; const bf16x2_cv b = __builtin_convertvector(v, bf16x2_cv); return __builtin_bit_cast(unsigned, b); }
__device__ __forceinline__ int crow(int r, int h) { return (r & 3) + 8 * (r >> 2) + 4 * h; }
typedef short v4i16_t __attribute__((ext_vector_type(4)));
__device__ __forceinline__ s16x4 vtr(const LAS char* p) { return __builtin_bit_cast(s16x4, __builtin_amdgcn_ds_read_tr16_b64_v4i16((LAS v4i16_t*)p)); }
constexpr int VBUF_BYTES = 4096, WSF_OFF = 8 * VBUF_BYTES;

__device__ __forceinline__ void tile(Frame& F, int b, int hs, int g, int res, int i0, LAS char* vbuf, LAS float* wsf) {
    int lane = F.lane; asm volatile("" : "+v"(lane));
    const int q = lane & 31, h = lane >> 5;
    const int sh = 2 * g, sub_len = SEQ >> sh;
    const int colg = g * 512 + hs * 64;
    const size_t rowb = (size_t)b * SEQ;
    const float slope2 = exp2f(-8.0f * (float)(g * 8 + hs + 1) / 24.0f) * LOG2E * (float)(1 << sh);
    const size_t qrow = rowb + (((size_t)(i0 + q)) << sh) + res;
    const bf16* Qp = F.Q + qrow * DQKV + colg + 8 * h;
    bf16x8 qf[4];
#pragma unroll
    for (int ks = 0; ks < 4; ++ks) qf[ks] = *(const bf16x8*)(Qp + 16 * ks);
    const bool edge = (i0 < 64) || (i0 + 96 > sub_len);
    const float qh = (float)(q - 4 * h);
    f32x16 s[5];
#pragma unroll
    for (int kb = 0; kb < 5; ++kb) {
        int kidx = i0 - 64 + 32 * kb + q; kidx = kidx < 0 ? 0 : (kidx >= sub_len ? sub_len - 1 : kidx);
        const bf16* Kp = F.KB + (rowb + (((size_t)kidx) << sh) + res) * DQKV + colg + 8 * h;
        bf16x8 kf[4];
#pragma unroll
        for (int ks = 0; ks < 4; ++ks) kf[ks] = *(const bf16x8*)(Kp + 16 * ks);
        f32x16 acc = {0.f, 0.f, 0.f, 0.f, 0.f, 0.f, 0.f, 0.f, 0.f, 0.f, 0.f, 0.f, 0.f, 0.f, 0.f, 0.f};
#pragma unroll
        for (int ks = 0; ks < 4; ++ks) acc = __builtin_amdgcn_mfma_f32_32x32x16_bf16(kf[ks], qf[ks], acc, 0, 0, 0);
#pragma unroll
        for (int r = 0; r < 16; ++r) {
            const float arel = fabsf((float)(32 * (kb - 2) + (r & 3) + 8 * (r >> 2)) - qh);
            float v = acc[r] - slope2 * arel;
            if (kb == 0 || kb == 4) v = arel <= 64.0f ? v : -1e30f;
            acc[r] = v;
        }
        if (edge) {
#pragma unroll
            for (int r = 0; r < 16; ++r) { const int ki = i0 - 64 + 32 * kb + crow(r, h); acc[r] = (ki >= 0 && ki < sub_len) ? acc[r] : -1e30f; }
        }
        s[kb] = acc;
        asm volatile("" ::: "memory");
    }
    float m = s[0][0];
#pragma unroll
    for (int kb = 0; kb < 5; ++kb)
#pragma unroll
        for (int r = 0; r < 16; ++r) m = fmaxf(m, s[kb][r]);
    m = fmaxf(m, __shfl_xor(m, 32));
    float l = 0.f;
#pragma unroll
    for (int kb = 0; kb < 5; ++kb)
#pragma unroll
        for (int r = 0; r < 16; ++r) { const float p = __builtin_amdgcn_exp2f(s[kb][r] - m); s[kb][r] = p; l += p; }
    l += __shfl_xor(l, 32);
    f32x16 o[2];
#pragma unroll
    for (int d = 0; d < 2; ++d) o[d] = (f32x16){0.f, 0.f, 0.f, 0.f, 0.f, 0.f, 0.f, 0.f, 0.f, 0.f, 0.f, 0.f, 0.f, 0.f, 0.f, 0.f};
    const LAS char* vrd = vbuf + ((lane >> 4) & 1) * 32 + (lane & 3) * 8 + (4 * h + ((lane & 15) >> 2)) * 64;
#pragma unroll
    for (int kb = 0; kb < 5; ++kb) {
        v4u vv[4];
#pragma unroll
        for (int i = 0; i < 4; ++i) {
            int kidx = i0 - 64 + 32 * kb + 16 * (i & 1) + (lane >> 2); kidx = kidx < 0 ? 0 : (kidx >= sub_len ? sub_len - 1 : kidx);
            vv[i] = *(const v4u*)(F.VB + (rowb + (((size_t)kidx) << sh) + res) * DQKV + colg + (i >> 1) * 32 + (lane & 3) * 8);
        }
        asm volatile("s_waitcnt lgkmcnt(0)" ::: "memory");
#pragma unroll
        for (int i = 0; i < 4; ++i) *(LAS v4u*)(vbuf + i * 1024 + lane * 16) = vv[i];
        asm volatile("s_waitcnt lgkmcnt(0)" ::: "memory");
#pragma unroll
        for (int s2 = 0; s2 < 2; ++s2) {
            const f32x16& p = s[kb];
            unsigned pw[4];
#pragma unroll
            for (int j = 0; j < 4; ++j) pw[j] = cvtpk(p[8 * s2 + 2 * j], p[8 * s2 + 2 * j + 1]);
            const bf16x8 pa = __builtin_bit_cast(bf16x8, (v4u){pw[0], pw[1], pw[2], pw[3]});
#pragma unroll
            for (int d = 0; d < 2; ++d) {
                const s16x4 lo = vtr(vrd + d * 2048 + s2 * 1024), hi = vtr(vrd + d * 2048 + s2 * 1024 + 512);
                const bf16x8 vf = {lo[0], lo[1], lo[2], lo[3], hi[0], hi[1], hi[2], hi[3]};
                o[d] = __builtin_amdgcn_mfma_f32_32x32x16_bf16(pa, vf, o[d], 0, 0, 0);
            }
        }
        asm volatile("" ::: "memory");
    }
    asm volatile("s_waitcnt lgkmcnt(0)" ::: "memory");
    if (h == 0) wsf[q] = 1.0f / l;
    asm volatile("s_waitcnt lgkmcnt(0)" ::: "memory");
#pragma unroll
    for (int r = 0; r < 16; ++r) { const int qq = crow(r, h); const float il = wsf[qq];
#pragma unroll
        for (int d = 0; d < 2; ++d) *(LAS bf16*)(vbuf + qq * 128 + (d * 32 + q) * 2) = (bf16)f2bf(o[d][r] * il); }
    asm volatile("s_waitcnt lgkmcnt(0)" ::: "memory");
#pragma unroll
    for (int i = 0; i < 4; ++i) { const int row = i * 8 + (lane >> 3), ch = lane & 7;
        const v4u v = *(const LAS v4u*)(vbuf + row * 128 + ch * 16);
        *(v4u*)(F.Q + (rowb + (((size_t)(i0 + row)) << sh) + res) * DQKV + colg + ch * 8) = v; }
    if (h == 0) F.LSE[((size_t)g * M + qrow) * 8 + hs] = m + log2f(l);
    asm volatile("s_waitcnt lgkmcnt(0)" ::: "memory");
}

__device__ __forceinline__ void unit(Frame& F, int u) {
    const int b = u >> 7, hs = (u >> 4) & 7, blk = u & 15, base = blk * 512;
    LAS char* vbuf = (LAS char*)(F.lds + RING_OFF) + F.wave * VBUF_BYTES;
    LAS float* wsf = (LAS float*)(F.lds + RING_OFF + WSF_OFF) + F.wave * 64;
#pragma unroll 1
    for (int g = 0; g < 3; ++g)
#pragma unroll 1
        for (int jj = 0; jj < 2; ++jj) {
            const int j = 2 * F.wave + jj, sh = 2 * g;
            const int res = j & ((1 << sh) - 1), jb = j >> sh;
            tile(F, b, hs, g, res, (base >> sh) + 32 * jb, vbuf, wsf);
        }
    VM_WAIT(); __syncthreads();
    if (F.tid == 0) { __builtin_amdgcn_fence(__ATOMIC_ACQUIRE, "agent"); VM_WAIT(); }
    __syncthreads();
    for (int it = 0; it < 8; ++it) {
        const int item = it * NTHREADS + F.tid, tok = item >> 3, ch = item & 7;
        const size_t row = (size_t)b * SEQ + base + tok;
        float ls[3];
#pragma unroll
        for (int g = 0; g < 3; ++g) ls[g] = F.LSE[((size_t)g * M + row) * 8 + hs];
        const float mx = fmaxf(ls[0], fmaxf(ls[1], ls[2]));
        float w[3], ws_ = 0.f;
#pragma unroll
        for (int g = 0; g < 3; ++g) { w[g] = exp2f(ls[g] - mx); ws_ += w[g]; }
        const float inv = 1.0f / ws_;
        float acc[8];
#pragma unroll
        for (int e = 0; e < 8; ++e) acc[e] = 0.f;
#pragma unroll
        for (int g = 0; g < 3; ++g) { const v4u v = *(const v4u*)(F.Q + row * DQKV + g * 512 + hs * 64 + ch * 8); const float wg = w[g] * inv;
#pragma unroll
            for (int e = 0; e < 4; ++e) { acc[2 * e] += wg * __uint_as_float(v[e] << 16); acc[2 * e + 1] += wg * __uint_as_float(v[e] & 0xffff0000u); } }
        v4u o; o.x = pk2(acc[0], acc[1]); o.y = pk2(acc[2], acc[3]); o.z = pk2(acc[4], acc[5]); o.w = pk2(acc[6], acc[7]);
        *(v4u*)(F.ZC + row * 1536 + 1024 + hs * 64 + ch * 8) = o;
    }
    __syncthreads();
}
__device__ __forceinline__ void phase(Frame& F) { for (int u = F.vcu; u < 256; u += F.G) unit(F, u); }
}
__device__ __forceinline__ void za_phase(Frame& F) {
    const int ch = (F.tid & 127) * 8;
    float w0[8], w1[8], w2[8];
#pragma unroll
    for (int e = 0; e < 8; ++e) { w0[e] = F.conv_w[ch + e]; w1[e] = F.conv_w[D + ch + e]; w2[e] = F.conv_w[2 * D + ch + e]; }
    for (int t = F.vcu * 4 + (F.tid >> 7); t < M; t += F.G * 4) {
        const int tt = t & (SEQ - 1);
        const v4u zero = {0u, 0u, 0u, 0u};
        const v4u um = tt > 0 ? *(const v4u*)(F.U + (size_t)(t - 1) * D + ch) : zero, u0 = *(const v4u*)(F.U + (size_t)t * D + ch), up = tt < SEQ - 1 ? *(const v4u*)(F.U + (size_t)(t + 1) * D + ch) : zero;
        const v4u bg = *(const v4u*)(F.ZC + (size_t)t * 1536 + ch);
        float r[8];
#pragma unroll
        for (int e = 0; e < 4; ++e) {
            const float c0 = w0[2 * e] * __uint_as_float(um[e] << 16) + w1[2 * e] * __uint_as_float(u0[e] << 16) + w2[2 * e] * __uint_as_float(up[e] << 16);
            const float c1 = w0[2 * e + 1] * __uint_as_float(um[e] & 0xffff0000u) + w1[2 * e + 1] * __uint_as_float(u0[e] & 0xffff0000u) + w2[2 * e + 1] * __uint_as_float(up[e] & 0xffff0000u);
            r[2 * e] = __uint_as_float(bg[e] << 16) * c0; r[2 * e + 1] = __uint_as_float(bg[e] & 0xffff0000u) * c1;
        }
        v4u o; o.x = pk2(r[0], r[1]); o.y = pk2(r[2], r[3]); o.z = pk2(r[4], r[5]); o.w = pk2(r[6], r[7]);
        *(v4u*)(F.ZC + (size_t)t * 1536 + ch) = o;
    }
}

#ifndef NV_P1
#define NV_P2 0
#define NV_P1 0
#define NV_P3 0
#define NV_P4 0
#define NV_P5 0
#define NV_P7 0
#define NV_P9 0
#endif
struct Args { const float* in[20]; float* out; unsigned char* ws; int ph_lo, ph_hi; };
constexpr int NPHASE = 11;
__global__ void __launch_bounds__(NTHREADS, 2) mk_fwd(Args args) {
    extern __shared__ __attribute__((aligned(16))) unsigned char lds[];
    Frame F;
    F.lds = (LAS unsigned char*)lds; F.MISC = (volatile LAS unsigned*)(F.lds + MISC_OFF);
    F.tid = threadIdx.x; F.lane = F.tid & 63; F.wave = __builtin_amdgcn_readfirstlane(F.tid >> 6);
    F.G = gridDim.x; { const int bx = blockIdx.x; F.vcu = (F.G % 8 == 0) ? (bx % 8) * (F.G / 8) + bx / 8 : bx; }
    unsigned char* ws = args.ws;
    F.ctl = (gu32*)(ws + WS_CTL);
    F.x = args.in[0]; F.ln0_g = args.in[1]; F.ln0_b = args.in[2]; F.w_in = args.in[3]; F.b_in = args.in[4]; F.conv_w = args.in[5]; F.w_a = args.in[6]; F.w_b = args.in[7];
    F.w_o = args.in[8]; F.b_o = args.in[9]; F.ln1_g = args.in[10]; F.ln1_b = args.in[11]; F.w_up = args.in[12]; F.b_up = args.in[13]; F.fcw = args.in[14]; F.fcb = args.in[15];
    F.w_dn = args.in[16]; F.b_dn = args.in[17]; F.ln2_g = args.in[18]; F.ln2_b = args.in[19]; F.out = args.out;
    F.ST0 = (float*)(ws + WS_ST0); F.BIASP = (float*)(ws + WS_BIASP); F.BUPP = (float*)(ws + WS_BUPP); F.LSE = (float*)(ws + WS_LSE);
    F.WUP = (bf16*)(ws + WS_WUP); F.WDN = (bf16*)(ws + WS_WDN); F.WIN = (bf16*)(ws + WS_WIN); F.WAB = (bf16*)(ws + WS_WAB); F.WO = (bf16*)(ws + WS_WO);
    F.XN = (bf16*)(ws + WS_XN); F.ZC = (bf16*)(ws + WS_ZC); F.U = (bf16*)(ws + WS_U); F.Q = (bf16*)(ws + WS_Q); F.KB = (bf16*)(ws + WS_K); F.VB = (bf16*)args.out;
    F.G_ = (bf16*)(ws + WS_G); F.MG = (bf16*)(ws + WS_MG); F.A1 = (bf16*)(ws + WS_A1); F.GT = (bf16*)(ws + WS_GT);
    for (int u = F.tid; u < (LDS_BYTES - LDSCTL_OFF) / 4; u += NTHREADS) ((LAS unsigned*)(F.lds + LDSCTL_OFF))[u] = 0u;
    __syncthreads();
    XcdBarrier bar = xcd_barrier_post((unsigned*)(F.ctl + CW_BAR), F.MISC + 8);
    const int lo = args.ph_lo, hi = args.ph_hi;
#define IN(k) (lo <= (k) && (k) < hi)
#define SEAM(k) do { if (IN(k) && IN((k) + 1)) xcd_barrier(bar); } while (0)
    if (IN(0)) { p0_prologue(F); } SEAM(0);
    if (IN(1)) {
#if NV_P1
        nv_proj(F, 0, NP1);
#else
        pg8::Gemm g{F.XN, F.WIN, M, NP1, D}; pg8::StaticOrder S; S.init(M, NP1, F.G, (int)blockIdx.x);
        pg8::EpiProj E{F.ZC, F.U, F.Q, F.KB, F.VB, F.BIASP, QSCALE};
        pg8::gemm_phase<pg8::EpiProj, pg8::StaticOrder, true, true>(F.lds + RING_OFF, g, S, E);
#endif
    } SEAM(1);
    if (IN(2)) {
#if NV_P2
        nv_attn(F); nv_za(F);
#else
        att::phase(F); za_phase(F);
#endif
    } SEAM(2);
    if (IN(3)) {
#if NV_P3
        nv_proj(F, NP1, NG);
#else
        pg8::Gemm g{F.XN, F.WIN + (size_t)NP1 * D, M, NG, D}; pg8::StaticOrder S; S.init(M, NG, F.G, (int)blockIdx.x);
        pg8::EpiSig E{F.G_, F.BIASP + NP1};
        pg8::gemm_phase<pg8::EpiSig, pg8::StaticOrder, true, true>(F.lds + RING_OFF, g, S, E);
#endif
    } SEAM(3);
    if (IN(4)) {
#if NV_P4
        nv_merge(F);
#else
        pg8::Gemm g{F.ZC, F.WAB, M, D, 1536}; pg8::StaticOrder S; S.init(M, D, F.G, (int)blockIdx.x);
        pg8::EpiMerge E{F.G_, F.MG};
        pg8::gemm_phase<pg8::EpiMerge, pg8::StaticOrder, true, true>(F.lds + RING_OFF, g, S, E);
#endif
    } SEAM(4);
    if (IN(5)) {
#if NV_P5
        nv_mix(F);
#else
        pg8::Gemm g{F.MG, F.WO, M, D, D}; pg8::StaticOrder S; S.init(M, D, F.G, (int)blockIdx.x);
        pg8::EpiMix E{F.x, F.ST0, F.ln0_g, F.ln0_b, F.b_o, F.out, ALPHA};
        pg8::gemm_phase<pg8::EpiMix, pg8::StaticOrder, true, true>(F.lds + RING_OFF, g, S, E);
#endif
    } SEAM(5);
    if (IN(6)) { ln_phase(F, F.ln1_g, F.ln1_b, F.XN); } SEAM(6);
    if (IN(7)) {
#if NV_P7
        nv_up(F);
#else
        pg8::Gemm g{F.XN, F.WUP, M, NUP, D}; pg8::StaticOrder S; S.init(M, NUP, F.G, (int)blockIdx.x);
        pg8::EpiUp E{F.A1, F.GT, F.BUPP};
        pg8::gemm_phase<pg8::EpiUp, pg8::StaticOrder, true, true>(F.lds + RING_OFF, g, S, E);
#endif
    } SEAM(7);
    if (IN(8)) { nv_f(F); } SEAM(8);
    if (IN(9)) {
#if NV_P9
        nv_down(F);
#else
        pg8::Gemm g{F.GT, F.WDN, M, D, DFF}; pg8::StaticOrder S; S.init(M, D, F.G, (int)blockIdx.x);
        pg8::EpiDown E{F.out, F.b_dn, ALPHA};
        pg8::gemm_phase<pg8::EpiDown, pg8::StaticOrder, true, true>(F.lds + RING_OFF, g, S, E);
#endif
    } SEAM(9);
    if (IN(10)) { ln_phase(F, F.ln2_g, F.ln2_b, nullptr); }
#undef IN
#undef SEAM
}

extern "C" void kernel_launch(void* const* d_in, const int* in_sizes, int n_in, void* d_out, int out_size, void* d_ws, size_t ws_size, hipStream_t stream) {
    static int grid = 0;
    if (grid == 0) {
        if (n_in != 20 || in_sizes[0] != M * D || out_size != M * D || ws_size < WS_END) { fprintf(stderr, "kernel_launch: unexpected shapes (n_in %d out %d ws %zu); nothing launched\n", n_in, out_size, ws_size); grid = -1; return; }
        int dev = 0, cus = 0, per_cu = 0;
        if (hipGetDevice(&dev) != hipSuccess || hipDeviceGetAttribute(&cus, hipDeviceAttributeMultiprocessorCount, dev) != hipSuccess) { grid = -1; return; }
        if (hipFuncSetAttribute((const void*)mk_fwd, hipFuncAttributeMaxDynamicSharedMemorySize, LDS_BYTES) != hipSuccess) { fprintf(stderr, "kernel_launch: hipFuncSetAttribute failed\n"); grid = -1; return; }
        if (hipOccupancyMaxActiveBlocksPerMultiprocessor(&per_cu, (const void*)mk_fwd, NTHREADS, LDS_BYTES) != hipSuccess || per_cu < 1) { fprintf(stderr, "kernel_launch: occupancy query says %d workgroups per CU\n", per_cu); per_cu = 1; }
        (void)hipGetLastError();
        grid = cus;
    }
    if (grid < 0) return;
    if (hipMemsetAsync((char*)d_ws + WS_CTL, 0, CTL_ZERO_BYTES, stream) != hipSuccess) { fprintf(stderr, "kernel_launch: memset failed\n"); return; }
    Args a{};
    for (int i = 0; i < 20; ++i) a.in[i] = (const float*)d_in[i];
    a.out = (float*)d_out; a.ws = (unsigned char*)d_ws; a.ph_lo = 0; a.ph_hi = NPHASE;
    hipLaunchKernelGGL(mk_fwd, dim3(grid), dim3(NTHREADS), LDS_BYTES, stream, a);
}
```

```cpp
#include <hip/hip_runtime.h>
#include <cstdio>
#include <cstdint>

typedef unsigned short bf16;
typedef unsigned v4u __attribute__((ext_vector_type(4)));
typedef float f32x4 __attribute__((ext_vector_type(4)));

constexpr int BATCH = 2, SEQ = 8192, D = 1024, M = BATCH * SEQ;
constexpr int DQKV = 1536, DFF = 2816, NIN = 9728, NP1 = 7680, NG = 2048, NUP = 2 * DFF;
constexpr int OFF_B = 0, OFF_C = 1024, OFF_H = 2048, OFF_Q = 3072, OFF_K = 4608, OFF_V = 6144, OFF_GA = 7680, OFF_GB = 8704;
constexpr float LN_EPS = 1e-5f;
constexpr float ALPHA = 1.189207115002721f;
constexpr float LOG2E = 1.4426950408889634f;
constexpr float QSCALE = 0.125f * LOG2E;

constexpr size_t MiB = 1u << 20;
constexpr size_t WS_CTL = 0;
constexpr size_t WS_ST0 = 512 * 1024;
constexpr size_t WS_BIASP = 640 * 1024;
constexpr size_t WS_BUPP = 704 * 1024;
constexpr size_t WS_WUP = 1 * MiB;
constexpr size_t WS_WDN = 12 * MiB;
constexpr size_t WS_WIN = 18 * MiB;
constexpr size_t WS_WAB = 37 * MiB;
constexpr size_t WS_WO = 40 * MiB;
constexpr size_t WS_XN = 42 * MiB;
constexpr size_t WS_ZC = 74 * MiB;
constexpr size_t WS_U = 122 * MiB;
constexpr size_t WS_Q = 154 * MiB;
constexpr size_t WS_K = 202 * MiB;
constexpr size_t WS_G = 122 * MiB;
constexpr size_t WS_MG = 202 * MiB;
constexpr size_t WS_A1 = 74 * MiB;
constexpr size_t WS_GT = 162 * MiB;
constexpr size_t WS_LSE = 250 * MiB;
constexpr size_t WS_END = 252 * MiB;

__device__ __forceinline__ float bf2f(bf16 v) { return __uint_as_float((unsigned)v << 16); }
__device__ __forceinline__ unsigned f2bf(float f) { unsigned u = __float_as_uint(f); return (u + 0x7fffu + ((u >> 16) & 1u)) >> 16; }
__device__ __forceinline__ unsigned pk2(float lo, float hi) { return f2bf(lo) | (f2bf(hi) << 16); }

__host__ __device__ __forceinline__ int win_row(int n) {
    if (n >= OFF_C && n < OFF_H) { const int c = n - OFF_C; return 1024 + 256 * (c >> 7) + (c & 127); }
    if (n >= OFF_H && n < OFF_Q) { const int c = n - OFF_H; return 1024 + 256 * (c >> 7) + 128 + (c & 127); }
    return n;
}
__host__ __device__ __forceinline__ int wup_row(int n) {
    if (n < DFF) return 256 * (n >> 7) + (n & 127);
    const int c = n - DFF; return 256 * (c >> 7) + 128 + (c & 127);
}

#define GAS __attribute__((address_space(1)))
#define LAS __attribute__((address_space(3)))
typedef GAS unsigned gu32;
#define RLX_AGENT __ATOMIC_RELAXED, __HIP_MEMORY_SCOPE_AGENT
#define LDS_WAIT() asm volatile("s_waitcnt lgkmcnt(0)" ::: "memory")
#define VM_WAIT() asm volatile("s_waitcnt vmcnt(0)" ::: "memory")

constexpr int NWAVES = 8, NTHREADS = NWAVES * 64;
constexpr size_t CTL_ZERO_BYTES = 256 * 1024;
constexpr int CW_BAR = 4096;
constexpr int RING_OFF = 0, RING_BYTES = 131072;
constexpr int LDSCTL_OFF = RING_BYTES, MISC_OFF = LDSCTL_OFF + 320;
constexpr int LDS_BYTES = 147456;

#define XB_TMO      128
#define XB_XCNT(j)  (256  + 64 * (j))
#define XB_XSUB(j)  (1280 + 64 * (j))
#define XB_XGEN(j)  (2304 + 64 * (j))
#define XB_TOP      3328
#define XB_TOPGEN   3392
#define XCD_BAR_WORDS 3456
#define XB_SPIN_CAP (1u << 18)
__device__ __forceinline__ unsigned xb_ld(unsigned* p)              { return __hip_atomic_load(p, __ATOMIC_RELAXED, __HIP_MEMORY_SCOPE_AGENT); }
__device__ __forceinline__ unsigned xb_add(unsigned* p, unsigned v) { return __hip_atomic_fetch_add(p, v, __ATOMIC_RELAXED, __HIP_MEMORY_SCOPE_AGENT); }
__device__ __forceinline__ unsigned xb_xcc_id() { return (unsigned)__builtin_amdgcn_s_getreg((3 << 11) | 20) & 0xFu; }
#define XB_SPIN(cond, bar) do { unsigned _sp = 0; while (cond) { __builtin_amdgcn_s_sleep(1); \
    if ((++_sp & 255u) == 0u) { if (xb_ld(&(bar)[XB_TMO])) break; if (_sp > XB_SPIN_CAP) { atomicAdd(&(bar)[XB_TMO], 1u); break; } } } } while (0)
struct XcdBarrier { unsigned* bar; unsigned x; volatile LAS unsigned* st; };
__device__ __forceinline__ XcdBarrier xcd_barrier_post(unsigned* bar, volatile LAS unsigned* st) {
    XcdBarrier b; b.bar = bar; b.x = xb_xcc_id(); b.st = st;
    if (threadIdx.x == 0) (void)xb_add(&bar[XB_XCNT(b.x)], 1u);
    return b;
}
__device__ __forceinline__ void xcd_barrier_complete(unsigned* bar, unsigned x, unsigned& nloc, unsigned& nx) {
    const unsigned G = gridDim.x * gridDim.y * gridDim.z;
    unsigned sum, cnt, mine, sp = 0u;
    for (;;) {
        sum = 0u; cnt = 0u; mine = 0u;
#pragma unroll
        for (unsigned j = 0; j < 16; ++j) { const unsigned c = xb_ld(&bar[XB_XCNT(j)]); sum += c; cnt += (c > 0u) ? 1u : 0u; mine = (j == x) ? c : mine; }
        if (sum == G) break;
        __builtin_amdgcn_s_sleep(1);
        if ((++sp & 255u) == 0u) { if (xb_ld(&bar[XB_TMO])) break; if (sp > XB_SPIN_CAP) { atomicAdd(&bar[XB_TMO], 1u); break; } }
    }
    nloc = mine > 0u ? mine : 1u; nx = cnt > 0u ? cnt : 1u;
}
__device__ __forceinline__ void xcd_barrier(const XcdBarrier& b) {
    asm volatile("s_waitcnt vmcnt(0)" ::: "memory");
    __syncthreads();
    if (threadIdx.x == 0) {
        unsigned* bar = b.bar;
        __builtin_amdgcn_s_waitcnt(0);
        unsigned nloc = b.st[0], nx = b.st[1];
        if (nloc == 0u) { xcd_barrier_complete(bar, b.x, nloc, nx); b.st[0] = nloc; b.st[1] = nx; }
        const unsigned old = xb_add(&bar[XB_XSUB(b.x)], 1u);
        const unsigned gen = old / nloc;
        if (old + 1u == (gen + 1u) * nloc) {
            __builtin_amdgcn_fence(__ATOMIC_RELEASE, "agent");
            asm volatile("s_waitcnt vmcnt(0)" ::: "memory");
            const unsigned og = xb_add(&bar[XB_TOP], 1u);
            const unsigned tg = og / nx;
            if (og + 1u == (tg + 1u) * nx) xb_add(&bar[XB_TOPGEN], 1u);
            else XB_SPIN(xb_ld(&bar[XB_TOPGEN]) == tg, bar);
            __builtin_amdgcn_fence(__ATOMIC_ACQUIRE, "agent");
            xb_add(&bar[XB_XGEN(b.x)], 1u);
            asm volatile("s_waitcnt vmcnt(0)" ::: "memory");
        } else {
            XB_SPIN(xb_ld(&bar[XB_XGEN(b.x)]) == gen, bar);
            __builtin_amdgcn_fence(__ATOMIC_ACQUIRE, "agent");
            asm volatile("s_waitcnt vmcnt(0)" ::: "memory");
        }
    }
    __syncthreads();
}

namespace pg8 {
#define PG8_LAS __attribute__((address_space(3)))
typedef unsigned short bf16_t;
typedef short bf16x8 __attribute__((ext_vector_type(8)));
typedef float f32x4 __attribute__((ext_vector_type(4)));
typedef unsigned u32x4 __attribute__((ext_vector_type(4)));
constexpr int BM = 256, BK = 64, HALF = 128, HTB = HALF * BK * 2  , STAGE_BYTES = 8 * HTB, NXCD = 8, WGM = 8;

__host__ __device__ __forceinline__ int lds_byte(int r, int c) { const int st = (r >> 4) * 2 + (c >> 5), rr = r & 15, cc = c & 31, ob = rr * 64 + cc * 2; return st * 1024 + (ob ^ (((ob >> 9) & 1) << 5)); }
__host__ __device__ __forceinline__ void stage_rc(int b, int& R, int& C) { const int st = b / 1024, sb = b % 1024, swz = sb ^ (((sb >> 9) & 1) << 5); R = (st >> 1) * 16 + swz / 64; C = (st & 1) * 32 + (swz % 64) / 2; }
__host__ __device__ __forceinline__ int perm32(int rho) { const int n = rho >> 4, i = rho & 15; return 8 * (i >> 2) + 4 * n + (i & 3); }

struct Unit { int pm, pn; };
struct Gemm { const bf16_t* A; const bf16_t* Bt; int M, N, K; };

struct StaticOrder {
    int nM, nN, nwg, G, c;
    __host__ __device__ void init(int M, int N, int G_, int c_) { nM = M / BM; nN = N / BM; nwg = nM * nN; G = G_; c = c_; }
    __host__ __device__ bool next(int i, Unit& u) const {
        const long L = (long)i * G + c; if (L >= nwg) return false;
        int wgid = (int)L; { const int q = nwg / NXCD, r = nwg % NXCD, xcd = wgid % NXCD, off = wgid / NXCD; wgid = (xcd < r ? xcd * (q + 1) : r * (q + 1) + (xcd - r) * q) + off; }
        const int nig = WGM * nN, gid = wgid / nig, fm = gid * WGM, gsz = (nM - fm) < WGM ? (nM - fm) : WGM;
        u.pm = fm + ((wgid % nig) % gsz); u.pn = (wgid % nig) / gsz; return true;
    }
    __device__ __forceinline__ void a_ready(const Unit&) const {}
    __device__ __forceinline__ void done(const Unit&) const {}
};

typedef float f32x2_cv __attribute__((ext_vector_type(2))); typedef __bf16 bf16x2_cv __attribute__((ext_vector_type(2)));
__device__ __forceinline__ unsigned cvt_pk_bf16(float lo, float hi) { const f32x2_cv v = {lo, hi}; const bf16x2_cv b = __builtin_convertvector(v, bf16x2_cv); return __builtin_bit_cast(unsigned, b); }
typedef float f32x2 __attribute__((ext_vector_type(2)));
__device__ __forceinline__ f32x2 gelu_pk(f32x2 v) {
    const f32x2 av = __builtin_elementwise_abs(v), d = av * 0.2316418882f + 1.0f;
    f32x2 t; t.x = __builtin_amdgcn_rcpf(d.x); t.y = __builtin_amdgcn_rcpf(d.y);
    f32x2 q = t * 0.5307027145f + (-0.7265760135f); q = q * t + 0.7107068705f; q = q * t + (-0.142248368f); q = q * t + 0.127414796f; q = q * t;
    const f32x2 s = (v * v) * (-0.72134752044f);
    f32x2 e; e.x = __builtin_amdgcn_exp2f(s.x); e.y = __builtin_amdgcn_exp2f(s.y);
    const f32x2 m = v * (q * e), r = v - m;
    f32x2 o; o.x = v.x < 0.f ? m.x : r.x; o.y = v.y < 0.f ? m.y : r.y; return o;
}


typedef unsigned u32x2 __attribute__((ext_vector_type(2)));
__device__ __forceinline__ u32x4 pack8(const f32x4 v0, const f32x4 v1) { u32x4 w; w.x = cvt_pk_bf16(v0[0], v0[1]); w.y = cvt_pk_bf16(v0[2], v0[3]); w.z = cvt_pk_bf16(v1[0], v1[1]); w.w = cvt_pk_bf16(v1[2], v1[3]); return w; }
__device__ __forceinline__ float bflo(unsigned w) { return __uint_as_float(w << 16); }
__device__ __forceinline__ float bfhi(unsigned w) { return __uint_as_float(w & 0xffff0000u); }
struct EpiProj {
    static constexpr bool PERM = true, AFTER_DRAIN = false; static constexpr int MIDK = 0;
    bf16_t *ZC, *U, *Q, *K, *V; const float* bias; float qscale;
    __device__ __forceinline__ void operator()(const f32x4 (&acc)[2][2][4][2], const Unit& u, int wr, int wc, int fr, int fq) const {
        const int row0 = u.pm * BM + wr * 64 + fr, cw = wc * 32 + 8 * fq, pn = u.pn;
        f32x4 bv[2][2];
#pragma unroll
        for (int bj = 0; bj < 2; ++bj)
#pragma unroll
            for (int n = 0; n < 2; ++n) bv[bj][n] = *(const f32x4*)(bias + pn * BM + bj * HALF + cw + 4 * n);
        if (pn >= 4 && pn < 12) {
            bf16_t* base = U + (pn - 4) * HALF + cw;
#pragma unroll
            for (int ai = 0; ai < 2; ++ai)
#pragma unroll
                for (int m = 0; m < 4; ++m) { bf16_t* rowp = base + (size_t)(row0 + ai * HALF + m * 16) * 1024;
                    const f32x4 v0 = (acc[ai][0][m][0] + bv[0][0]) * (acc[ai][1][m][0] + bv[1][0]), v1 = (acc[ai][0][m][1] + bv[0][1]) * (acc[ai][1][m][1] + bv[1][1]);
                    *(u32x4*)rowp = pack8(v0, v1); }
            return;
        }
        bf16_t* base; int ldc; float sc = 1.f;
        if (pn < 4) { base = ZC + pn * BM; ldc = 1536; }
        else if (pn < 18) { base = Q + (pn - 12) * BM; ldc = 1536; sc = qscale; }
        else if (pn < 24) { base = K + (pn - 18) * BM; ldc = 1536; }
        else { base = V + (pn - 24) * BM; ldc = 1536; }
        base += cw;
#pragma unroll
        for (int ai = 0; ai < 2; ++ai)
#pragma unroll
            for (int m = 0; m < 4; ++m) { bf16_t* rowp = base + (size_t)(row0 + ai * HALF + m * 16) * ldc;
#pragma unroll
                for (int bj = 0; bj < 2; ++bj) *(u32x4*)(rowp + bj * HALF) = pack8((acc[ai][bj][m][0] + bv[bj][0]) * sc, (acc[ai][bj][m][1] + bv[bj][1]) * sc); }
    }
};
struct EpiSig {
    static constexpr bool PERM = true, AFTER_DRAIN = false; static constexpr int MIDK = 0;
    bf16_t* G; const float* bias;
    __device__ __forceinline__ void operator()(const f32x4 (&acc)[2][2][4][2], const Unit& u, int wr, int wc, int fr, int fq) const {
        const int row0 = u.pm * BM + wr * 64 + fr, col0 = u.pn * BM + wc * 32 + 8 * fq;
        f32x4 bv[2][2];
#pragma unroll
        for (int bj = 0; bj < 2; ++bj)
#pragma unroll
            for (int n = 0; n < 2; ++n) bv[bj][n] = *(const f32x4*)(bias + col0 + bj * HALF + 4 * n);
#pragma unroll
        for (int ai = 0; ai < 2; ++ai)
#pragma unroll
            for (int m = 0; m < 4; ++m) { bf16_t* rowp = G + (size_t)(row0 + ai * HALF + m * 16) * 2048 + col0;
#pragma unroll
                for (int bj = 0; bj < 2; ++bj) { f32x4 v[2];
#pragma unroll
                    for (int n = 0; n < 2; ++n) { const f32x4 x = acc[ai][bj][m][n] + bv[bj][n];
#pragma unroll
                        for (int j = 0; j < 4; ++j) v[n][j] = __builtin_amdgcn_rcpf(1.0f + __builtin_amdgcn_exp2f(x[j] * -1.4426950408889634f)); }
                    *(u32x4*)(rowp + bj * HALF) = pack8(v[0], v[1]); } }
    }
};
struct EpiMerge {
    static constexpr bool PERM = true, AFTER_DRAIN = false; static constexpr int MIDK = 16;
    const bf16_t* G; bf16_t* MG;
    __device__ __forceinline__ void mid(f32x4 (&acc)[2][2][4][2], const Unit& u, int wr, int wc, int fr, int fq) const {
        const char* Gb = (const char*)G;
        asm volatile("" : "+v"(fr), "+v"(fq));
        const unsigned off0 = ((unsigned)(u.pm * BM + wr * 64 + fr) * 2048u + (unsigned)(u.pn * BM + wc * 32 + 8 * fq)) * 2u;
#pragma unroll
        for (int ai = 0; ai < 2; ++ai)
#pragma unroll
            for (int m = 0; m < 4; ++m)
#pragma unroll
                for (int bj = 0; bj < 2; ++bj) { const unsigned off = off0 + (unsigned)((ai * HALF + m * 16) * 2048 + bj * HALF) * 2u;
                    const u32x4 ga = *(const u32x4*)(Gb + off), gb = *(const u32x4*)(Gb + off + 2048u);
#pragma unroll
                    for (int w = 0; w < 4; ++w) { const float r0 = bflo(ga[w]) * __builtin_amdgcn_rcpf(bflo(gb[w])), r1 = bfhi(ga[w]) * __builtin_amdgcn_rcpf(bfhi(gb[w]));
                        acc[ai][bj][m][w >> 1][(w & 1) * 2] *= r0; acc[ai][bj][m][w >> 1][(w & 1) * 2 + 1] *= r1; }
                    asm volatile("" ::: "memory"); }
    }
    __device__ __forceinline__ void operator()(const f32x4 (&acc)[2][2][4][2], const Unit& u, int wr, int wc, int fr, int fq) const {
        asm volatile("" : "+v"(fr), "+v"(fq));
        const int row0 = u.pm * BM + wr * 64 + fr, col0 = u.pn * BM + wc * 32 + 8 * fq;
#pragma unroll
        for (int ai = 0; ai < 2; ++ai)
#pragma unroll
            for (int m = 0; m < 4; ++m) { const size_t ro = (size_t)(row0 + ai * HALF + m * 16);
#pragma unroll
                for (int bj = 0; bj < 2; ++bj) { const u32x4 gb = *(const u32x4*)(G + ro * 2048 + 1024 + col0 + bj * HALF);
                    const f32x4 g0 = {bflo(gb[0]), bfhi(gb[0]), bflo(gb[1]), bfhi(gb[1])}, g1 = {bflo(gb[2]), bfhi(gb[2]), bflo(gb[3]), bfhi(gb[3])};
                    *(u32x4*)(MG + ro * 1024 + col0 + bj * HALF) = pack8(acc[ai][bj][m][0] * g0, acc[ai][bj][m][1] * g1); } }
    }
};
struct EpiMix {
    static constexpr bool PERM = false, AFTER_DRAIN = false; static constexpr int MIDK = 0;
    const float *x, *st, *g0, *b0, *bo; float* R1; float alpha;
    __device__ __forceinline__ void operator()(const f32x4 (&acc)[2][2][4][2], const Unit& u, int wr, int wc, int fr, int fq) const {
        const int row0 = u.pm * BM + wr * 64 + fr, col0 = u.pn * BM + wc * 32 + 4 * fq;
        f32x4 gv[2][2], bv[2][2];
#pragma unroll
        for (int bj = 0; bj < 2; ++bj)
#pragma unroll
            for (int n = 0; n < 2; ++n) { const int c = col0 + bj * HALF + n * 16; gv[bj][n] = *(const f32x4*)(g0 + c) * alpha; bv[bj][n] = *(const f32x4*)(b0 + c) * alpha + *(const f32x4*)(bo + c); }
#pragma unroll
        for (int ai = 0; ai < 2; ++ai)
#pragma unroll
            for (int m = 0; m < 4; ++m) { const size_t ro = (size_t)(row0 + ai * HALF + m * 16); const float mean = st[2 * ro], rstd = st[2 * ro + 1];
#pragma unroll
                for (int bj = 0; bj < 2; ++bj)
#pragma unroll
                    for (int n = 0; n < 2; ++n) { const size_t off = ro * 1024 + col0 + bj * HALF + n * 16; const f32x4 xv = *(const f32x4*)(x + off);
                        *(f32x4*)(R1 + off) = (xv - mean) * rstd * gv[bj][n] + bv[bj][n] + acc[ai][bj][m][n]; } }
    }
};
struct EpiUp {
    static constexpr bool PERM = true, AFTER_DRAIN = false; static constexpr int MIDK = 0;
    bf16_t *A1, *GT; const float* bias;
    __device__ __forceinline__ void operator()(const f32x4 (&acc)[2][2][4][2], const Unit& u, int wr, int wc, int fr, int fq) const {
        const int row0 = u.pm * BM + wr * 64 + fr, cw = wc * 32 + 8 * fq, ch0 = u.pn * HALF + cw;
        f32x4 bv[2][2];
#pragma unroll
        for (int bj = 0; bj < 2; ++bj)
#pragma unroll
            for (int n = 0; n < 2; ++n) bv[bj][n] = *(const f32x4*)(bias + u.pn * BM + bj * HALF + cw + 4 * n);
#pragma unroll
        for (int ai = 0; ai < 2; ++ai)
#pragma unroll
            for (int m = 0; m < 4; ++m) { const size_t ro = (size_t)(row0 + ai * HALF + m * 16) * 2816 + ch0;
                *(u32x4*)(A1 + ro) = pack8(acc[ai][0][m][0] + bv[0][0], acc[ai][0][m][1] + bv[0][1]);
                *(u32x4*)(GT + ro) = pack8(acc[ai][1][m][0] + bv[1][0], acc[ai][1][m][1] + bv[1][1]); }
    }
};
struct EpiDown {
    static constexpr bool PERM = false, AFTER_DRAIN = false; static constexpr int MIDK = 0;
    float* H; const float* bd; float alpha;
    __device__ __forceinline__ void operator()(const f32x4 (&acc)[2][2][4][2], const Unit& u, int wr, int wc, int fr, int fq) const {
        const int row0 = u.pm * BM + wr * 64 + fr, col0 = u.pn * BM + wc * 32 + 4 * fq;
        f32x4 bv[2][2];
#pragma unroll
        for (int bj = 0; bj < 2; ++bj)
#pragma unroll
            for (int n = 0; n < 2; ++n) bv[bj][n] = *(const f32x4*)(bd + col0 + bj * HALF + n * 16);
#pragma unroll
        for (int ai = 0; ai < 2; ++ai)
#pragma unroll
            for (int m = 0; m < 4; ++m) { const size_t ro = (size_t)(row0 + ai * HALF + m * 16) * 1024 + col0;
#pragma unroll
                for (int bj = 0; bj < 2; ++bj)
#pragma unroll
                    for (int n = 0; n < 2; ++n) { float* p = H + ro + bj * HALF + n * 16; *(f32x4*)p = *(const f32x4*)p * alpha + acc[ai][bj][m][n] + bv[bj][n]; } }
    }
};

template <class Epi, class Sched, bool ALIGN_EPI = false, bool SP2 = false>
__device__ __forceinline__ void gemm_phase(PG8_LAS unsigned char* lds, const Gemm g, const Sched& S, const Epi& E) {
    const int tid = threadIdx.x, wid = __builtin_amdgcn_readfirstlane(tid >> 6), lane = tid & 63, wr = wid >> 2, wc = wid & 3, fr = lane & 15, fq = lane >> 4;
    const int K = g.K, nt = K / BK;
    unsigned voffA[2], voffB[2];
#pragma unroll
    for (int i = 0; i < 2; ++i) { int R, C; stage_rc(tid * 16 + i * 8192, R, C); const int Rb = Epi::PERM ? ((R & ~31) + perm32(R & 31)) : R;
        voffA[i] = (unsigned)(R * K + C) * 2u; voffB[i] = (unsigned)(Rb * K + C) * 2u; }
    const size_t kstep = (size_t)(BK * 2);
    const size_t hstep = (size_t)HALF * K * 2;
    const size_t tstep = 2 * hstep;
    const unsigned ldsw = (unsigned)wid * 1024u;
    const int aoff = lds_byte(wr * 64 + fr, fq * 8), boff = lds_byte(wc * 32 + fr, fq * 8);
#define PG8_SA(b, h) (((b) * 2 + (h)) * HTB)
#define PG8_SB(b, h) ((4 + (b) * 2 + (h)) * HTB)
#define PG8_STAGE(bufoff, gbase, voff) do { _Pragma("unroll") for (int _i = 0; _i < 2; ++_i) \
        __builtin_amdgcn_global_load_lds((const unsigned*)((const char*)(gbase) + (voff)[_i]), (PG8_LAS unsigned*)(lds + (bufoff) + ldsw + _i * 8192), 16, 0, 0); } while (0)
#define PG8_LDA(dst, b, h) do { _Pragma("unroll") for (int m = 0; m < 4; ++m) _Pragma("unroll") for (int k = 0; k < 2; ++k) dst[m][k] = *(const PG8_LAS bf16x8*)(lds + PG8_SA(b, h) + aoff + m * 2048 + k * 1024); } while (0)
#define PG8_LDB(dst, b, h) do { _Pragma("unroll") for (int n = 0; n < 2; ++n) _Pragma("unroll") for (int k = 0; k < 2; ++k) dst[n][k] = *(const PG8_LAS bf16x8*)(lds + PG8_SB(b, h) + boff + n * 2048 + k * 1024); } while (0)
#define PG8_MMA(ai, bj, At, Bt) do { __builtin_amdgcn_s_setprio(1); _Pragma("unroll") for (int m = 0; m < 4; ++m) _Pragma("unroll") for (int n = 0; n < 2; ++n) _Pragma("unroll") for (int k = 0; k < 2; ++k) \
        acc[ai][bj][m][n] = __builtin_amdgcn_mfma_f32_16x16x32_bf16(Bt[n][k], At[m][k], acc[ai][bj][m][n], 0, 0, 0); __builtin_amdgcn_s_setprio(0); } while (0)
#define PG8_WAIT_V(n) asm volatile("s_waitcnt vmcnt(" #n ")" ::: "memory")
#define PG8_WAIT_L(n) asm volatile("s_waitcnt lgkmcnt(" #n ")" ::: "memory")
#define PG8_BAR __builtin_amdgcn_s_barrier()
#define PG8_SCHED __builtin_amdgcn_sched_barrier(0)
    Unit cur, nxt; int ui = 0;
    if (!S.next(0, cur)) return;
    f32x4 acc[2][2][4][2];
#pragma unroll
    for (int a = 0; a < 2; ++a)
#pragma unroll
        for (int b = 0; b < 2; ++b)
#pragma unroll
            for (int m = 0; m < 4; ++m)
#pragma unroll
                for (int n = 0; n < 2; ++n) acc[a][b][m][n] = (f32x4){0.f, 0.f, 0.f, 0.f};
    bf16x8 At[4][2], B0[2][2], B1[2][2];
    const char* cA = (const char*)g.A + (size_t)cur.pm * tstep; const char* cB = (const char*)g.Bt + (size_t)cur.pn * tstep;
    S.a_ready(cur);
    if constexpr (SP2) {
        PG8_STAGE(PG8_SB(0, 0), cB, voffB); PG8_STAGE(PG8_SB(0, 1), cB + hstep, voffB); PG8_STAGE(PG8_SA(0, 0), cA, voffA); PG8_STAGE(PG8_SA(0, 1), cA + hstep, voffA);
        if (wr == 1) PG8_BAR;
        PG8_WAIT_V(2); PG8_BAR;
        PG8_STAGE(PG8_SB(1, 0), cB + kstep, voffB); PG8_STAGE(PG8_SA(1, 0), cA + kstep, voffA); PG8_STAGE(PG8_SB(1, 1), cB + hstep + kstep, voffB);
        PG8_WAIT_V(6); PG8_BAR;
    } else {
        PG8_STAGE(PG8_SB(0, 0), cB, voffB); PG8_STAGE(PG8_SA(0, 0), cA, voffA); PG8_STAGE(PG8_SB(0, 1), cB + hstep, voffB); PG8_STAGE(PG8_SA(0, 1), cA + hstep, voffA);
        if (wr == 1) PG8_BAR;
        PG8_WAIT_V(4); PG8_BAR;
        PG8_STAGE(PG8_SB(1, 0), cB + kstep, voffB); PG8_STAGE(PG8_SA(1, 0), cA + kstep, voffA); PG8_STAGE(PG8_SB(1, 1), cB + hstep + kstep, voffB);
        PG8_WAIT_V(6); PG8_BAR;
    }
    for (;;) {
        const bool has_next = S.next(ui + 1, nxt);
        const char* nA = has_next ? (const char*)g.A + (size_t)nxt.pm * tstep : cA; const char* nB = has_next ? (const char*)g.Bt + (size_t)nxt.pn * tstep : cB;
        constexpr int NSEG = Epi::MIDK > 0 ? 2 : 1;
        for (int seg = 0; seg < NSEG; ++seg) {
        const int tb = (seg == 0) ? 0 : Epi::MIDK, te = (NSEG == 2 && seg == 0) ? Epi::MIDK : nt;
        for (int t = tb; t < te; t += 2) {
            const bool last = (t == nt - 2);
            const char* a1 = cA + (size_t)(t + 1) * kstep;
            const char* a2 = last ? nA : cA + (size_t)(t + 2) * kstep; const char* b2 = last ? nB : cB + (size_t)(t + 2) * kstep;
            const char* a3 = a2 + kstep; const char* b3 = b2 + kstep;
            if (last && has_next) S.a_ready(nxt);
            if constexpr (SP2) {
            PG8_LDB(B0, 0, 0); PG8_LDB(B1, 0, 1); PG8_SCHED; PG8_LDA(At, 0, 0); PG8_STAGE(PG8_SA(1, 1), a1 + hstep, voffA);
            PG8_WAIT_V(8); PG8_WAIT_L(0); PG8_BAR; PG8_MMA(0, 0, At, B0); PG8_MMA(0, 1, At, B1); PG8_BAR; PG8_SCHED;
            PG8_LDA(At, 0, 1); PG8_STAGE(PG8_SB(0, 0), b2, voffB); PG8_STAGE(PG8_SB(0, 1), b2 + hstep, voffB); PG8_STAGE(PG8_SA(0, 0), a2, voffA);
            PG8_WAIT_V(8); PG8_WAIT_L(0); PG8_BAR; PG8_MMA(1, 0, At, B0); PG8_MMA(1, 1, At, B1); PG8_BAR; PG8_SCHED;
            PG8_LDB(B0, 1, 0); PG8_LDB(B1, 1, 1); PG8_SCHED; PG8_LDA(At, 1, 0); PG8_STAGE(PG8_SA(0, 1), a2 + hstep, voffA);
            PG8_WAIT_V(8); PG8_WAIT_L(0); PG8_BAR; PG8_MMA(0, 0, At, B0); PG8_MMA(0, 1, At, B1); PG8_BAR; PG8_SCHED;
            PG8_LDA(At, 1, 1); PG8_STAGE(PG8_SB(1, 0), b3, voffB); PG8_STAGE(PG8_SB(1, 1), b3 + hstep, voffB); PG8_STAGE(PG8_SA(1, 0), a3, voffA);
            PG8_WAIT_V(8); PG8_WAIT_L(0); PG8_BAR; PG8_MMA(1, 0, At, B0); PG8_MMA(1, 1, At, B1); PG8_BAR; PG8_SCHED;
            } else {
            PG8_LDB(B0, 0, 0); PG8_SCHED; PG8_LDA(At, 0, 0); PG8_STAGE(PG8_SA(1, 1), a1 + hstep, voffA);
            PG8_WAIT_L(8); PG8_BAR; PG8_WAIT_L(0); PG8_MMA(0, 0, At, B0); PG8_BAR; PG8_SCHED;
            PG8_LDB(B1, 0, 1); PG8_STAGE(PG8_SB(0, 0), b2, voffB);
            PG8_BAR; PG8_WAIT_L(0); PG8_MMA(0, 1, At, B1); PG8_BAR;
            PG8_LDA(At, 0, 1); PG8_STAGE(PG8_SA(0, 0), a2, voffA);
            PG8_BAR; PG8_WAIT_L(0); PG8_MMA(1, 0, At, B0); PG8_BAR; PG8_SCHED;
            PG8_STAGE(PG8_SB(0, 1), b2 + hstep, voffB);
            PG8_WAIT_V(6); PG8_BAR; PG8_MMA(1, 1, At, B1); PG8_BAR;
            PG8_LDB(B0, 1, 0); PG8_SCHED; PG8_LDA(At, 1, 0); PG8_STAGE(PG8_SA(0, 1), a2 + hstep, voffA);
            PG8_WAIT_L(8); PG8_BAR; PG8_WAIT_L(0); PG8_MMA(0, 0, At, B0); PG8_BAR; PG8_SCHED;
            PG8_LDB(B1, 1, 1); PG8_STAGE(PG8_SB(1, 0), b3, voffB);
            PG8_BAR; PG8_WAIT_L(0); PG8_MMA(0, 1, At, B1); PG8_BAR;
            PG8_LDA(At, 1, 1); PG8_STAGE(PG8_SA(1, 0), a3, voffA);
            PG8_BAR; PG8_WAIT_L(0); PG8_MMA(1, 0, At, B0); PG8_BAR; PG8_SCHED;
            PG8_STAGE(PG8_SB(1, 1), b3 + hstep, voffB);
            PG8_WAIT_V(6); PG8_BAR; PG8_MMA(1, 1, At, B1); PG8_BAR;
            }
        }
        if constexpr (Epi::MIDK > 0) { if (seg == 0) E.mid(acc, cur, wr, wc, fr, fq); }
        }
        if constexpr (ALIGN_EPI) { if (wr == 0) PG8_BAR; }
        if constexpr (!Epi::AFTER_DRAIN) { E(acc, cur, wr, wc, fr, fq); S.done(cur); }
        if (!has_next) break;
#pragma unroll
        for (int a = 0; a < 2; ++a)
#pragma unroll
            for (int b = 0; b < 2; ++b)
#pragma unroll
                for (int m = 0; m < 4; ++m)
#pragma unroll
                    for (int n = 0; n < 2; ++n) acc[a][b][m][n] = (f32x4){0.f, 0.f, 0.f, 0.f};
        cur = nxt; cA = nA; cB = nB; ++ui;
        if constexpr (ALIGN_EPI) { if (wr == 1) PG8_BAR; }
    }
    PG8_WAIT_V(0);
    if constexpr (!ALIGN_EPI) { if (wr == 0) PG8_BAR; }
    PG8_BAR;
    if constexpr (Epi::AFTER_DRAIN) { E.fused(acc, cur, wr, wc, fr, fq, lds, wid, lane); S.done(cur); }
#undef PG8_SA
#undef PG8_SB
#undef PG8_STAGE
#undef PG8_LDA
#undef PG8_LDB
#undef PG8_MMA
#undef PG8_WAIT_V
#undef PG8_WAIT_L
#undef PG8_BAR
#undef PG8_SCHED
}
}

struct Frame {
    LAS unsigned char* lds; volatile LAS unsigned* MISC; gu32* ctl;
    int tid, lane, wave, vcu, G;
    const float *x, *ln0_g, *ln0_b, *w_in, *b_in, *conv_w, *w_a, *w_b, *w_o, *b_o, *ln1_g, *ln1_b, *w_up, *b_up, *fcw, *fcb, *w_dn, *b_dn, *ln2_g, *ln2_b;
    float* out; float *ST0, *BIASP, *BUPP, *LSE;
    bf16 *WUP, *WDN, *WIN, *WAB, *WO, *XN, *ZC, *U, *Q, *KB, *VB, *G_, *MG, *A1, *GT;
};
__device__ __forceinline__ float wave_sum(float v) {
#pragma unroll
    for (int o = 1; o < 64; o <<= 1) v += __shfl_xor(v, o);
    return v;
}
__device__ __forceinline__ void p0_transpose_item(const float* W, int K, int N, bf16* WT, int ldk, int koff, int mode, LAS float* scr, int item, int lane) {
    const int nblk = N / 32, kb = item / nblk, nb = item % nblk, k0 = 64 * kb, n0 = 32 * nb;
    const int r0 = mode == 1 ? win_row(n0) : mode == 2 ? wup_row(n0) : n0;
#pragma unroll 8
    for (int i = 0; i < 32; ++i) { const int kk = 2 * i + (lane >> 5); scr[kk * 33 + (lane & 31)] = W[(size_t)(k0 + kk) * N + n0 + (lane & 31)]; }
    LDS_WAIT(); asm volatile("" ::: "memory");
    const int c = lane & 7;
#pragma unroll
    for (int j = 0; j < 4; ++j) { const int n = (lane >> 3) + 8 * j; const LAS float* s = scr + (8 * c) * 33 + n;
        v4u o; o.x = pk2(s[0 * 33], s[1 * 33]); o.y = pk2(s[2 * 33], s[3 * 33]); o.z = pk2(s[4 * 33], s[5 * 33]); o.w = pk2(s[6 * 33], s[7 * 33]);
        *(GAS v4u*)(WT + (size_t)(r0 + n) * ldk + koff + k0 + 8 * c) = o; }
    LDS_WAIT(); asm volatile("" ::: "memory");
}
__device__ __forceinline__ void ln_row(const float* xrow, const float* g, const float* b, float* of32, bf16* obf, float* st, int lane) {
    const GAS f32x4* xr = (const GAS f32x4*)xrow + lane;
    f32x4 v[4]; float s = 0.f;
#pragma unroll
    for (int j = 0; j < 4; ++j) { v[j] = xr[64 * j]; s += (v[j].x + v[j].y) + (v[j].z + v[j].w); }
    const float mean = wave_sum(s) * (1.f / D); float s2 = 0.f;
#pragma unroll
    for (int j = 0; j < 4; ++j) { v[j] = v[j] - mean; s2 += (v[j].x * v[j].x + v[j].y * v[j].y) + (v[j].z * v[j].z + v[j].w * v[j].w); }
    const float rstd = 1.f / sqrtf(wave_sum(s2) * (1.f / D) + LN_EPS);
    if (st && lane == 0) { st[0] = mean; st[1] = rstd; }
#pragma unroll
    for (int j = 0; j < 4; ++j) {
        const f32x4 gg = ((const GAS f32x4*)g)[lane + 64 * j], bb = ((const GAS f32x4*)b)[lane + 64 * j];
        const f32x4 y = v[j] * rstd * gg + bb;
        if (of32) ((GAS f32x4*)of32)[lane + 64 * j] = y;
        if (obf) ((GAS unsigned long long*)obf)[lane + 64 * j] = (unsigned long long)pk2(y.x, y.y) | ((unsigned long long)pk2(y.z, y.w) << 32);
    }
}
__device__ __forceinline__ void p0_prologue(Frame& F) {
    LAS float* scr = (LAS float*)(F.lds + RING_OFF + F.wave * 16384);
    const int gw = F.vcu * NWAVES + F.wave, NGW = F.G * NWAVES;
    constexpr int I_IN = (D / 64) * (NIN / 32), I_A = (D / 64) * (D / 32), I_B = (512 / 64) * (D / 32), I_O = I_A, I_UP = (D / 64) * (NUP / 32), I_DN = (DFF / 64) * (D / 32);
    constexpr int NITEMS = I_IN + I_A + I_B + I_O + I_UP + I_DN;
    for (int it = gw; it < NITEMS; it += NGW) {
        int r = it;
        if (r < I_IN) { p0_transpose_item(F.w_in, D, NIN, F.WIN, D, 0, 1, scr, r, F.lane); continue; } r -= I_IN;
        if (r < I_A) { p0_transpose_item(F.w_a, D, D, F.WAB, 1536, 0, 0, scr, r, F.lane); continue; } r -= I_A;
        if (r < I_B) { p0_transpose_item(F.w_b, 512, D, F.WAB, 1536, 1024, 0, scr, r, F.lane); continue; } r -= I_B;
        if (r < I_O) { p0_transpose_item(F.w_o, D, D, F.WO, D, 0, 0, scr, r, F.lane); continue; } r -= I_O;
        if (r < I_UP) { p0_transpose_item(F.w_up, D, NUP, F.WUP, D, 0, 2, scr, r, F.lane); continue; } r -= I_UP;
        p0_transpose_item(F.w_dn, DFF, D, F.WDN, DFF, 0, 0, scr, r, F.lane);
    }
    for (int i = F.vcu * NTHREADS + F.tid; i < NIN; i += F.G * NTHREADS) { F.BIASP[win_row(i)] = F.b_in[i]; if (i < NUP) F.BUPP[wup_row(i)] = F.b_up[i]; }
    for (int m = gw; m < M; m += NGW) ln_row(F.x + (size_t)m * D, F.ln0_g, F.ln0_b, nullptr, F.XN + (size_t)m * D, F.ST0 + 2 * m, F.lane);
}

template <int K>
__device__ __forceinline__ void nv_dot8(const bf16* __restrict__ A, int lda, const bf16* __restrict__ Brow, float (&acc)[8]) {
#pragma unroll
    for (int r = 0; r < 8; ++r) acc[r] = 0.f;
    for (int k = 0; k < K; k += 8) {
        const v4u bv = *(const v4u*)(Brow + k);
        float bfv[8];
#pragma unroll
        for (int j = 0; j < 4; ++j) { bfv[2 * j] = __uint_as_float(bv[j] << 16); bfv[2 * j + 1] = __uint_as_float(bv[j] & 0xffff0000u); }
#pragma unroll
        for (int r = 0; r < 8; ++r) {
            const v4u av = *(const v4u*)(A + (size_t)r * lda + k);
#pragma unroll
            for (int j = 0; j < 4; ++j) { acc[r] += __uint_as_float(av[j] << 16) * bfv[2 * j]; acc[r] += __uint_as_float(av[j] & 0xffff0000u) * bfv[2 * j + 1]; }
        }
    }
}
__device__ __forceinline__ float sigmoidf_(float v) { return 1.f / (1.f + __expf(-v)); }
#define NV_LOOP(nbx, nby) for (int vb_ = 2 * (int)blockIdx.x + (F.tid >> 8); vb_ < (nbx) * (nby); vb_ += 2 * F.G)
#define NV_BX(nbx) (vb_ % (nbx))
#define NV_BY(nbx) (vb_ / (nbx))
__device__ __forceinline__ void nv_proj(Frame& F, int n_off, int ncols) {
    const int t256 = F.tid & 255, nbx = ncols / 256;
    NV_LOOP(nbx, M / 8) {
        const int n = n_off + NV_BX(nbx) * 256 + t256, row0 = NV_BY(nbx) * 8;
        if (n >= 1024 && n < 3072) {
            if (t256 < 128) {
                float ac[8], ah[8]; nv_dot8<D>(F.XN + (size_t)row0 * D, D, F.WIN + (size_t)n * D, ac); nv_dot8<D>(F.XN + (size_t)row0 * D, D, F.WIN + (size_t)(n + 128) * D, ah);
                const float bc = F.BIASP[n], bh = F.BIASP[n + 128]; const int ch = 128 * ((n - 1024) >> 8) + t256;
#pragma unroll
                for (int r = 0; r < 8; ++r) F.U[(size_t)(row0 + r) * D + ch] = (bf16)f2bf((ac[r] + bc) * (ah[r] + bh));
            }
            continue;
        }
        float acc[8]; nv_dot8<D>(F.XN + (size_t)row0 * D, D, F.WIN + (size_t)n * D, acc);
        const float bs = F.BIASP[n];
#pragma unroll
        for (int r = 0; r < 8; ++r) {
            const float v = acc[r] + bs; const size_t row = row0 + r;
            if (n < 1024) F.ZC[row * 1536 + n] = (bf16)f2bf(v);
            else if (n < 4608) F.Q[row * DQKV + (n - 3072)] = (bf16)f2bf(v * QSCALE);
            else if (n < 6144) F.KB[row * DQKV + (n - 4608)] = (bf16)f2bf(v);
            else if (n < 7680) F.VB[row * DQKV + (n - 6144)] = (bf16)f2bf(v);
            else F.G_[row * NG + (n - 7680)] = (bf16)f2bf(sigmoidf_(v));
        }
    }
}
__device__ __forceinline__ void nv_za(Frame& F) {
    const int t256 = F.tid & 255;
    NV_LOOP(4, M) {
        const int ch = NV_BX(4) * 256 + t256, t = NV_BY(4), tt = t & (SEQ - 1);
        const float um = tt > 0 ? bf2f(F.U[(size_t)(t - 1) * D + ch]) : 0.f, u0 = bf2f(F.U[(size_t)t * D + ch]), up = tt < SEQ - 1 ? bf2f(F.U[(size_t)(t + 1) * D + ch]) : 0.f;
        const float cv = F.conv_w[ch] * um + F.conv_w[D + ch] * u0 + F.conv_w[2 * D + ch] * up;
        F.ZC[(size_t)t * 1536 + ch] = (bf16)f2bf(bf2f(F.ZC[(size_t)t * 1536 + ch]) * cv);
    }
}
__device__ __forceinline__ void nv_attn(Frame& F) {
    for (int wv = F.vcu * NWAVES + F.wave; wv < M * 8; wv += F.G * NWAVES) {
        const int lane = F.lane, t = wv >> 3, hs = wv & 7, bb = t / SEQ, tt = t - bb * SEQ;
        float m = -1e30f, l = 0.f, o = 0.f;
        for (int g = 0; g < 3; ++g) {
            const int dil = g == 0 ? 1 : g == 1 ? 4 : 16;
            const int col = g * 512 + hs * 64 + lane;
            const float slope2 = exp2f(-8.0f * (float)(g * 8 + hs + 1) / 24.0f) * LOG2E * (float)dil;
            const float q = bf2f(F.Q[(size_t)t * DQKV + col]);
            for (int j = -64; j <= 64; ++j) {
                const int ss = tt + j * dil;
                if (ss < 0 || ss >= SEQ) continue;
                const size_t kr = (size_t)(bb * SEQ + ss) * DQKV + col;
                const float s = wave_sum(q * bf2f(F.KB[kr])) - slope2 * (float)(j < 0 ? -j : j);
                const float mn = fmaxf(m, s), a = exp2f(m - mn), p = exp2f(s - mn);
                l = l * a + p; o = o * a + p * bf2f(F.VB[kr]); m = mn;
            }
        }
        F.ZC[(size_t)t * 1536 + 1024 + hs * 64 + lane] = (bf16)f2bf(o / l);
    }
}
__device__ __forceinline__ void nv_merge(Frame& F) {
    const int t256 = F.tid & 255;
    NV_LOOP(4, M / 8) {
        const int n = NV_BX(4) * 256 + t256, row0 = NV_BY(4) * 8;
        float a1[8], a2[8];
        nv_dot8<1024>(F.ZC + (size_t)row0 * 1536, 1536, F.WAB + (size_t)n * 1536, a1);
        nv_dot8<512>(F.ZC + (size_t)row0 * 1536 + 1024, 1536, F.WAB + (size_t)n * 1536 + 1024, a2);
#pragma unroll
        for (int r = 0; r < 8; ++r) { const size_t row = row0 + r;
            F.MG[row * D + n] = (bf16)f2bf(bf2f(F.G_[row * NG + n]) * a1[r] + bf2f(F.G_[row * NG + 1024 + n]) * a2[r]); }
    }
}
__device__ __forceinline__ void nv_mix(Frame& F) {
    const int t256 = F.tid & 255;
    NV_LOOP(4, M / 8) {
        const int n = NV_BX(4) * 256 + t256, row0 = NV_BY(4) * 8;
        float acc[8]; nv_dot8<D>(F.MG + (size_t)row0 * D, D, F.WO + (size_t)n * D, acc);
#pragma unroll
        for (int r = 0; r < 8; ++r) { const size_t row = row0 + r;
            const float h = (F.x[row * D + n] - F.ST0[2 * row]) * F.ST0[2 * row + 1] * F.ln0_g[n] + F.ln0_b[n];
            F.out[row * D + n] = ALPHA * h + acc[r] + F.b_o[n]; }
    }
}
__device__ __forceinline__ void nv_up(Frame& F) {
    const int t256 = F.tid & 255;
    NV_LOOP(NUP / 256, M / 8) {
        const int n = NV_BX(NUP / 256) * 256 + t256, row0 = NV_BY(NUP / 256) * 8;
        float acc[8]; nv_dot8<D>(F.XN + (size_t)row0 * D, D, F.WUP + (size_t)n * D, acc);
        const float bs = F.BUPP[n]; const int j = n >> 8, w = n & 255;
#pragma unroll
        for (int r = 0; r < 8; ++r) { const size_t row = row0 + r;
            if (w < 128) F.A1[row * DFF + 128 * j + w] = (bf16)f2bf(acc[r] + bs); else F.GT[row * DFF + 128 * j + w - 128] = (bf16)f2bf(acc[r] + bs); }
    }
}
__device__ __forceinline__ void nv_f(Frame& F) {
    const int t256 = F.tid & 255;
    NV_LOOP(DFF / 256, M) {
        const int ch = NV_BX(DFF / 256) * 256 + t256, t = NV_BY(DFF / 256), tt = t & (SEQ - 1);
        const float am = tt > 0 ? bf2f(F.A1[(size_t)(t - 1) * DFF + ch]) : 0.f, a0 = bf2f(F.A1[(size_t)t * DFF + ch]), ap = tt < SEQ - 1 ? bf2f(F.A1[(size_t)(t + 1) * DFF + ch]) : 0.f;
        const float v = F.fcw[ch] * am + F.fcw[DFF + ch] * a0 + F.fcw[2 * DFF + ch] * ap + F.fcb[ch];
        const float ge = 0.5f * v * (1.f + erff(v * 0.70710678118654752f));
        F.GT[(size_t)t * DFF + ch] = (bf16)f2bf(ge * bf2f(F.GT[(size_t)t * DFF + ch]));
    }
}
__device__ __forceinline__ void nv_down(Frame& F) {
    const int t256 = F.tid & 255;
    NV_LOOP(4, M / 8) {
        const int n = NV_BX(4) * 256 + t256, row0 = NV_BY(4) * 8;
        float acc[8]; nv_dot8<DFF>(F.GT + (size_t)row0 * DFF, DFF, F.WDN + (size_t)n * DFF, acc);
#pragma unroll
        for (int r = 0; r < 8; ++r) { const size_t row = row0 + r; F.out[row * D + n] = ALPHA * F.out[row * D + n] + acc[r] + F.b_dn[n]; }
    }
}
__device__ __forceinline__ void ln_phase(Frame& F, const float* g, const float* b, bf16* obf) {
    for (int m = F.vcu * NWAVES + F.wave; m < M; m += F.G * NWAVES) ln_row(F.out + (size_t)m * D, g, b, F.out + (size_t)m * D, obf ? obf + (size_t)m * D : nullptr, nullptr, F.lane);
}

namespace att {
typedef short bf16x8 __attribute__((ext_vector_type(8)));
typedef short s16x4 __attribute__((ext_vector_type(4)));
typedef float f32x16 __attribute__((ext_vector_type(16)));
typedef float f32x2_cv __attribute__((ext_vector_type(2))); typedef __bf16 bf16x2_cv __attribute__((ext_vector_type(2)));
__device__ __forceinline__ unsigned cvtpk(float lo, float hi) { const f32x2_cv v = {lo, hi}; const bf16x2_cv b = __builtin_convertvector(v, bf16x2_cv); return __builtin_bit_cast(unsigned, b); }
__device__ __forceinline__ int crow(int r, int h) { return (r & 3) + 8 * (r >> 2) + 4 * h; }
typedef short v4i16_t __attribute__((ext_vector_type(4)));
__device__ __forceinline__ s16x4 vtr(const LAS char* p) { return __builtin_bit_cast(s16x4, __builtin_amdgcn_ds_read_tr16_b64_v4i16((LAS v4i16_t*)p)); }
constexpr int VBUF_BYTES = 4096, WSF_OFF = 8 * VBUF_BYTES;

__device__ __forceinline__ void tile(Frame& F, int b, int hs, int g, int res, int i0, LAS char* vbuf, LAS float* wsf) {
    int lane = F.lane; asm volatile("" : "+v"(lane));
    const int q = lane & 31, h = lane >> 5;
    const int sh = 2 * g, sub_len = SEQ >> sh;
    const int colg = g * 512 + hs * 64;
    const size_t rowb = (size_t)b * SEQ;
    const float slope2 = exp2f(-8.0f * (float)(g * 8 + hs + 1) / 24.0f) * LOG2E * (float)(1 << sh);
    const size_t qrow = rowb + (((size_t)(i0 + q)) << sh) + res;
    const bf16* Qp = F.Q + qrow * DQKV + colg + 8 * h;
    bf16x8 qf[4];
#pragma unroll
    for (int ks = 0; ks < 4; ++ks) qf[ks] = *(const bf16x8*)(Qp + 16 * ks);
    const bool edge = (i0 < 64) || (i0 + 96 > sub_len);
    const float qh = (float)(q - 4 * h);
    f32x16 s[5];
#pragma unroll
    for (int kb = 0; kb < 5; ++kb) {
        int kidx = i0 - 64 + 32 * kb + q; kidx = kidx < 0 ? 0 : (kidx >= sub_len ? sub_len - 1 : kidx);
        const bf16* Kp = F.KB + (rowb + (((size_t)kidx) << sh) + res) * DQKV + colg + 8 * h;
        bf16x8 kf[4];
#pragma unroll
        for (int ks = 0; ks < 4; ++ks) kf[ks] = *(const bf16x8*)(Kp + 16 * ks);
        f32x16 acc = {0.f, 0.f, 0.f, 0.f, 0.f, 0.f, 0.f, 0.f, 0.f, 0.f, 0.f, 0.f, 0.f, 0.f, 0.f, 0.f};
#pragma unroll
        for (int ks = 0; ks < 4; ++ks) acc = __builtin_amdgcn_mfma_f32_32x32x16_bf16(kf[ks], qf[ks], acc, 0, 0, 0);
#pragma unroll
        for (int r = 0; r < 16; ++r) {
            const float arel = fabsf((float)(32 * (kb - 2) + (r & 3) + 8 * (r >> 2)) - qh);
            float v = acc[r] - slope2 * arel;
            if (kb == 0 || kb == 4) v = arel <= 64.0f ? v : -1e30f;
            acc[r] = v;
        }
        if (edge) {
#pragma unroll
            for (int r = 0; r < 16; ++r) { const int ki = i0 - 64 + 32 * kb + crow(r, h); acc[r] = (ki >= 0 && ki < sub_len) ? acc[r] : -1e30f; }
        }
        s[kb] = acc;
        asm volatile("" ::: "memory");
    }
    float m = s[0][0];
#pragma unroll
    for (int kb = 0; kb < 5; ++kb)
#pragma unroll
        for (int r = 0; r < 16; ++r) m = fmaxf(m, s[kb][r]);
    m = fmaxf(m, __shfl_xor(m, 32));
    float l = 0.f;
#pragma unroll
    for (int kb = 0; kb < 5; ++kb)
#pragma unroll
        for (int r = 0; r < 16; ++r) { const float p = __builtin_amdgcn_exp2f(s[kb][r] - m); s[kb][r] = p; l += p; }
    l += __shfl_xor(l, 32);
    f32x16 o[2];
#pragma unroll
    for (int d = 0; d < 2; ++d) o[d] = (f32x16){0.f, 0.f, 0.f, 0.f, 0.f, 0.f, 0.f, 0.f, 0.f, 0.f, 0.f, 0.f, 0.f, 0.f, 0.f, 0.f};
    const LAS char* vrd = vbuf + ((lane >> 4) & 1) * 32 + (lane & 3) * 8 + (4 * h + ((lane & 15) >> 2)) * 64;
#pragma unroll
    for (int kb = 0; kb < 5; ++kb) {
        v4u vv[4];
#pragma unroll
        for (int i = 0; i < 4; ++i) {
            int kidx = i0 - 64 + 32 * kb + 16 * (i & 1) + (lane >> 2); kidx = kidx < 0 ? 0 : (kidx >= sub_len ? sub_len - 1 : kidx);
            vv[i] = *(const v4u*)(F.VB + (rowb + (((size_t)kidx) << sh) + res) * DQKV + colg + (i >> 1) * 32 + (lane & 3) * 8);
        }
        asm volatile("s_waitcnt lgkmcnt(0)" ::: "memory");
#pragma unroll
        for (int i = 0; i < 4; ++i) *(LAS v4u*)(vbuf + i * 1024 + lane * 16) = vv[i];
        asm volatile("s_waitcnt lgkmcnt(0)" ::: "memory");
#pragma unroll
        for (int s2 = 0; s2 < 2; ++s2) {
            const f32x16& p = s[kb];
            unsigned pw[4];
#pragma unroll
            for (int j = 0; j < 4; ++j) pw[j] = cvtpk(p[8 * s2 + 2 * j], p[8 * s2 + 2 * j + 1]);
            const bf16x8 pa = __builtin_bit_cast(bf16x8, (v4u){pw[0], pw[1], pw[2], pw[3]});
#pragma unroll
            for (int d = 0; d < 2; ++d) {
                const s16x4 lo = vtr(vrd + d * 2048 + s2 * 1024), hi = vtr(vrd + d * 2048 + s2 * 1024 + 512);
                const bf16x8 vf = {lo[0], lo[1], lo[2], lo[3], hi[0], hi[1], hi[2], hi[3]};
                o[d] = __builtin_amdgcn_mfma_f32_32x32x16_bf16(pa, vf, o[d], 0, 0, 0);
            }
        }
        asm volatile("" ::: "memory");
    }
    asm volatile("s_waitcnt lgkmcnt(0)" ::: "memory");
    if (h == 0) wsf[q] = 1.0f / l;
    asm volatile("s_waitcnt lgkmcnt(0)" ::: "memory");
#pragma unroll
    for (int r = 0; r < 16; ++r) { const int qq = crow(r, h); const float il = wsf[qq];
#pragma unroll
        for (int d = 0; d < 2; ++d) *(LAS bf16*)(vbuf + qq * 128 + (d * 32 + q) * 2) = (bf16)f2bf(o[d][r] * il); }
    asm volatile("s_waitcnt lgkmcnt(0)" ::: "memory");
#pragma unroll
    for (int i = 0; i < 4; ++i) { const int row = i * 8 + (lane >> 3), ch = lane & 7;
        const v4u v = *(const LAS v4u*)(vbuf + row * 128 + ch * 16);
        *(v4u*)(F.Q + (rowb + (((size_t)(i0 + row)) << sh) + res) * DQKV + colg + ch * 8) = v; }
    if (h == 0) F.LSE[((size_t)g * M + qrow) * 8 + hs] = m + log2f(l);
    asm volatile("s_waitcnt lgkmcnt(0)" ::: "memory");
}

__device__ __forceinline__ void unit(Frame& F, int u) {
    const int b = u >> 7, hs = (u >> 4) & 7, blk = u & 15, base = blk * 512;
    LAS char* vbuf = (LAS char*)(F.lds + RING_OFF) + F.wave * VBUF_BYTES;
    LAS float* wsf = (LAS float*)(F.lds + RING_OFF + WSF_OFF) + F.wave * 64;
#pragma unroll 1
    for (int g = 0; g < 3; ++g)
#pragma unroll 1
        for (int jj = 0; jj < 2; ++jj) {
            const int j = 2 * F.wave + jj, sh = 2 * g;
            const int res = j & ((1 << sh) - 1), jb = j >> sh;
            tile(F, b, hs, g, res, (base >> sh) + 32 * jb, vbuf, wsf);
        }
    VM_WAIT(); __syncthreads();
    if (F.tid == 0) { __builtin_amdgcn_fence(__ATOMIC_ACQUIRE, "agent"); VM_WAIT(); }
    __syncthreads();
    for (int it = 0; it < 8; ++it) {
        const int item = it * NTHREADS + F.tid, tok = item >> 3, ch = item & 7;
        const size_t row = (size_t)b * SEQ + base + tok;
        float ls[3];
#pragma unroll
        for (int g = 0; g < 3; ++g) ls[g] = F.LSE[((size_t)g * M + row) * 8 + hs];
        const float mx = fmaxf(ls[0], fmaxf(ls[1], ls[2]));
        float w[3], ws_ = 0.f;
#pragma unroll
        for (int g = 0; g < 3; ++g) { w[g] = exp2f(ls[g] - mx); ws_ += w[g]; }
        const float inv = 1.0f / ws_;
        float acc[8];
#pragma unroll
        for (int e = 0; e < 8; ++e) acc[e] = 0.f;
#pragma unroll
        for (int g = 0; g < 3; ++g) { const v4u v = *(const v4u*)(F.Q + row * DQKV + g * 512 + hs * 64 + ch * 8); const float wg = w[g] * inv;
#pragma unroll
            for (int e = 0; e < 4; ++e) { acc[2 * e] += wg * __uint_as_float(v[e] << 16); acc[2 * e + 1] += wg * __uint_as_float(v[e] & 0xffff0000u); } }
        v4u o; o.x = pk2(acc[0], acc[1]); o.y = pk2(acc[2], acc[3]); o.z = pk2(acc[4], acc[5]); o.w = pk2(acc[6], acc[7]);
        *(v4u*)(F.ZC + row * 1536 + 1024 + hs * 64 + ch * 8) = o;
    }
    __syncthreads();
}
__device__ __forceinline__ void phase(Frame& F) { for (int u = F.vcu; u < 256; u += F.G) unit(F, u); }
}
__device__ __forceinline__ void za_phase(Frame& F) {
    const int ch = (F.tid & 127) * 8;
    float w0[8], w1[8], w2[8];
#pragma unroll
    for (int e = 0; e < 8; ++e) { w0[e] = F.conv_w[ch + e]; w1[e] = F.conv_w[D + ch + e]; w2[e] = F.conv_w[2 * D + ch + e]; }
    for (int t = F.vcu * 4 + (F.tid >> 7); t < M; t += F.G * 4) {
        const int tt = t & (SEQ - 1);
        const v4u zero = {0u, 0u, 0u, 0u};
        const v4u um = tt > 0 ? *(const v4u*)(F.U + (size_t)(t - 1) * D + ch) : zero, u0 = *(const v4u*)(F.U + (size_t)t * D + ch), up = tt < SEQ - 1 ? *(const v4u*)(F.U + (size_t)(t + 1) * D + ch) : zero;
        const v4u bg = *(const v4u*)(F.ZC + (size_t)t * 1536 + ch);
        float r[8];
#pragma unroll
        for (int e = 0; e < 4; ++e) {
            const float c0 = w0[2 * e] * __uint_as_float(um[e] << 16) + w1[2 * e] * __uint_as_float(u0[e] << 16) + w2[2 * e] * __uint_as_float(up[e] << 16);
            const float c1 = w0[2 * e + 1] * __uint_as_float(um[e] & 0xffff0000u) + w1[2 * e + 1] * __uint_as_float(u0[e] & 0xffff0000u) + w2[2 * e + 1] * __uint_as_float(up[e] & 0xffff0000u);
            r[2 * e] = __uint_as_float(bg[e] << 16) * c0; r[2 * e + 1] = __uint_as_float(bg[e] & 0xffff0000u) * c1;
        }
        v4u o; o.x = pk2(r[0], r[1]); o.y = pk2(r[2], r[3]); o.z = pk2(r[4], r[5]); o.w = pk2(r[6], r[7]);
        *(v4u*)(F.ZC + (size_t)t * 1536 + ch) = o;
    }
}

__device__ __forceinline__ float gelu_erf(float v) {
    const float av = fabsf(v), t = __builtin_amdgcn_rcpf(av * 0.2316418882f + 1.0f);
    float q = t * 0.5307027145f + (-0.7265760135f); q = q * t + 0.7107068705f; q = q * t + (-0.142248368f); q = q * t + 0.127414796f; q = q * t;
    const float e = __builtin_amdgcn_exp2f((v * v) * (-0.72134752044f)), m = v * (q * e);
    return v < 0.f ? m : v - m;
}
__device__ __forceinline__ void f_phase(Frame& F) {
    if (F.tid < DFF / 8) {
        const int ch = F.tid * 8;
        float w0[8], w1[8], w2[8], cb[8];
#pragma unroll
        for (int e = 0; e < 8; ++e) { w0[e] = F.fcw[ch + e]; w1[e] = F.fcw[DFF + ch + e]; w2[e] = F.fcw[2 * DFF + ch + e]; cb[e] = F.fcb[ch + e]; }
        for (int r0 = F.vcu * 64; r0 < M; r0 += F.G * 64) {
            const v4u zero = {0u, 0u, 0u, 0u};
            v4u am = (r0 & (SEQ - 1)) ? *(const v4u*)(F.A1 + (size_t)(r0 - 1) * DFF + ch) : zero, a0 = *(const v4u*)(F.A1 + (size_t)r0 * DFF + ch);
#pragma unroll 4
            for (int i = 0; i < 64; ++i) {
                const int t = r0 + i;
                const v4u ap = ((t + 1) & (SEQ - 1)) ? *(const v4u*)(F.A1 + (size_t)(t + 1) * DFF + ch) : zero;
                const v4u gt = *(const v4u*)(F.GT + (size_t)t * DFF + ch);
                float r[8];
#pragma unroll
                for (int e = 0; e < 4; ++e) {
                    const float c0 = w0[2 * e] * __uint_as_float(am[e] << 16) + w1[2 * e] * __uint_as_float(a0[e] << 16) + w2[2 * e] * __uint_as_float(ap[e] << 16) + cb[2 * e];
                    const float c1 = w0[2 * e + 1] * __uint_as_float(am[e] & 0xffff0000u) + w1[2 * e + 1] * __uint_as_float(a0[e] & 0xffff0000u) + w2[2 * e + 1] * __uint_as_float(ap[e] & 0xffff0000u) + cb[2 * e + 1];
                    r[2 * e] = gelu_erf(c0) * __uint_as_float(gt[e] << 16); r[2 * e + 1] = gelu_erf(c1) * __uint_as_float(gt[e] & 0xffff0000u);
                }
                v4u o; o.x = pk2(r[0], r[1]); o.y = pk2(r[2], r[3]); o.z = pk2(r[4], r[5]); o.w = pk2(r[6], r[7]);
                *(v4u*)(F.GT + (size_t)t * DFF + ch) = o;
                am = a0; a0 = ap;
            }
        }
    }
}

#ifndef NV_P1
#define NV_P2 0
#define NV_P1 0
#define NV_P3 0
#define NV_P4 0
#define NV_P5 0
#define NV_P7 0
#define NV_P9 0
#endif
struct Args { const float* in[20]; float* out; unsigned char* ws; int ph_lo, ph_hi; };
constexpr int NPHASE = 11;
__global__ void __launch_bounds__(NTHREADS, 2) mk_fwd(Args args) {
    extern __shared__ __attribute__((aligned(16))) unsigned char lds[];
    Frame F;
    F.lds = (LAS unsigned char*)lds; F.MISC = (volatile LAS unsigned*)(F.lds + MISC_OFF);
    F.tid = threadIdx.x; F.lane = F.tid & 63; F.wave = __builtin_amdgcn_readfirstlane(F.tid >> 6);
    F.G = gridDim.x; { const int bx = blockIdx.x; F.vcu = (F.G % 8 == 0) ? (bx % 8) * (F.G / 8) + bx / 8 : bx; }
    unsigned char* ws = args.ws;
    F.ctl = (gu32*)(ws + WS_CTL);
    F.x = args.in[0]; F.ln0_g = args.in[1]; F.ln0_b = args.in[2]; F.w_in = args.in[3]; F.b_in = args.in[4]; F.conv_w = args.in[5]; F.w_a = args.in[6]; F.w_b = args.in[7];
    F.w_o = args.in[8]; F.b_o = args.in[9]; F.ln1_g = args.in[10]; F.ln1_b = args.in[11]; F.w_up = args.in[12]; F.b_up = args.in[13]; F.fcw = args.in[14]; F.fcb = args.in[15];
    F.w_dn = args.in[16]; F.b_dn = args.in[17]; F.ln2_g = args.in[18]; F.ln2_b = args.in[19]; F.out = args.out;
    F.ST0 = (float*)(ws + WS_ST0); F.BIASP = (float*)(ws + WS_BIASP); F.BUPP = (float*)(ws + WS_BUPP); F.LSE = (float*)(ws + WS_LSE);
    F.WUP = (bf16*)(ws + WS_WUP); F.WDN = (bf16*)(ws + WS_WDN); F.WIN = (bf16*)(ws + WS_WIN); F.WAB = (bf16*)(ws + WS_WAB); F.WO = (bf16*)(ws + WS_WO);
    F.XN = (bf16*)(ws + WS_XN); F.ZC = (bf16*)(ws + WS_ZC); F.U = (bf16*)(ws + WS_U); F.Q = (bf16*)(ws + WS_Q); F.KB = (bf16*)(ws + WS_K); F.VB = (bf16*)args.out;
    F.G_ = (bf16*)(ws + WS_G); F.MG = (bf16*)(ws + WS_MG); F.A1 = (bf16*)(ws + WS_A1); F.GT = (bf16*)(ws + WS_GT);
    for (int u = F.tid; u < (LDS_BYTES - LDSCTL_OFF) / 4; u += NTHREADS) ((LAS unsigned*)(F.lds + LDSCTL_OFF))[u] = 0u;
    __syncthreads();
    XcdBarrier bar = xcd_barrier_post((unsigned*)(F.ctl + CW_BAR), F.MISC + 8);
    const int lo = args.ph_lo, hi = args.ph_hi;
#define IN(k) (lo <= (k) && (k) < hi)
#define SEAM(k) do { if (IN(k) && IN((k) + 1)) xcd_barrier(bar); } while (0)
    if (IN(0)) { p0_prologue(F); } SEAM(0);
    if (IN(1)) {
#if NV_P1
        nv_proj(F, 0, NP1);
#else
        pg8::Gemm g{F.XN, F.WIN, M, NP1, D}; pg8::StaticOrder S; S.init(M, NP1, F.G, (int)blockIdx.x);
        pg8::EpiProj E{F.ZC, F.U, F.Q, F.KB, F.VB, F.BIASP, QSCALE};
        pg8::gemm_phase<pg8::EpiProj, pg8::StaticOrder, true, true>(F.lds + RING_OFF, g, S, E);
#endif
    } SEAM(1);
    if (IN(2)) {
#if NV_P2
        nv_attn(F); nv_za(F);
#else
        att::phase(F); za_phase(F);
#endif
    } SEAM(2);
    if (IN(3)) {
#if NV_P3
        nv_proj(F, NP1, NG);
#else
        pg8::Gemm g{F.XN, F.WIN + (size_t)NP1 * D, M, NG, D}; pg8::StaticOrder S; S.init(M, NG, F.G, (int)blockIdx.x);
        pg8::EpiSig E{F.G_, F.BIASP + NP1};
        pg8::gemm_phase<pg8::EpiSig, pg8::StaticOrder, true, true>(F.lds + RING_OFF, g, S, E);
#endif
    } SEAM(3);
    if (IN(4)) {
#if NV_P4
        nv_merge(F);
#else
        pg8::Gemm g{F.ZC, F.WAB, M, D, 1536}; pg8::StaticOrder S; S.init(M, D, F.G, (int)blockIdx.x);
        pg8::EpiMerge E{F.G_, F.MG};
        pg8::gemm_phase<pg8::EpiMerge, pg8::StaticOrder, true, true>(F.lds + RING_OFF, g, S, E);
#endif
    } SEAM(4);
    if (IN(5)) {
#if NV_P5
        nv_mix(F);
#else
        pg8::Gemm g{F.MG, F.WO, M, D, D}; pg8::StaticOrder S; S.init(M, D, F.G, (int)blockIdx.x);
        pg8::EpiMix E{F.x, F.ST0, F.ln0_g, F.ln0_b, F.b_o, F.out, ALPHA};
        pg8::gemm_phase<pg8::EpiMix, pg8::StaticOrder, true, true>(F.lds + RING_OFF, g, S, E);
#endif
    } SEAM(5);
    if (IN(6)) { ln_phase(F, F.ln1_g, F.ln1_b, F.XN); } SEAM(6);
    if (IN(7)) {
#if NV_P7
        nv_up(F);
#else
        pg8::Gemm g{F.XN, F.WUP, M, NUP, D}; pg8::StaticOrder S; S.init(M, NUP, F.G, (int)blockIdx.x);
        pg8::EpiUp E{F.A1, F.GT, F.BUPP};
        pg8::gemm_phase<pg8::EpiUp, pg8::StaticOrder, true, true>(F.lds + RING_OFF, g, S, E);
#endif
    } SEAM(7);
    if (IN(8)) { f_phase(F); } SEAM(8);
    if (IN(9)) {
#if NV_P9
        nv_down(F);
#else
        pg8::Gemm g{F.GT, F.WDN, M, D, DFF}; pg8::StaticOrder S; S.init(M, D, F.G, (int)blockIdx.x);
        pg8::EpiDown E{F.out, F.b_dn, ALPHA};
        pg8::gemm_phase<pg8::EpiDown, pg8::StaticOrder, true, true>(F.lds + RING_OFF, g, S, E);
#endif
    } SEAM(9);
    if (IN(10)) { ln_phase(F, F.ln2_g, F.ln2_b, nullptr); }
#undef IN
#undef SEAM
}

extern "C" void kernel_launch(void* const* d_in, const int* in_sizes, int n_in, void* d_out, int out_size, void* d_ws, size_t ws_size, hipStream_t stream) {
    static int grid = 0;
    if (grid == 0) {
        if (n_in != 20 || in_sizes[0] != M * D || out_size != M * D || ws_size < WS_END) { fprintf(stderr, "kernel_launch: unexpected shapes (n_in %d out %d ws %zu); nothing launched\n", n_in, out_size, ws_size); grid = -1; return; }
        int dev = 0, cus = 0, per_cu = 0;
        if (hipGetDevice(&dev) != hipSuccess || hipDeviceGetAttribute(&cus, hipDeviceAttributeMultiprocessorCount, dev) != hipSuccess) { grid = -1; return; }
        if (hipFuncSetAttribute((const void*)mk_fwd, hipFuncAttributeMaxDynamicSharedMemorySize, LDS_BYTES) != hipSuccess) { fprintf(stderr, "kernel_launch: hipFuncSetAttribute failed\n"); grid = -1; return; }
        if (hipOccupancyMaxActiveBlocksPerMultiprocessor(&per_cu, (const void*)mk_fwd, NTHREADS, LDS_BYTES) != hipSuccess || per_cu < 1) { fprintf(stderr, "kernel_launch: occupancy query says %d workgroups per CU\n", per_cu); per_cu = 1; }
        (void)hipGetLastError();
        grid = cus;
    }
    if (grid < 0) return;
    if (hipMemsetAsync((char*)d_ws + WS_CTL, 0, CTL_ZERO_BYTES, stream) != hipSuccess) { fprintf(stderr, "kernel_launch: memset failed\n"); return; }
    Args a{};
    for (int i = 0; i < 20; ++i) a.in[i] = (const float*)d_in[i];
    a.out = (float*)d_out; a.ws = (unsigned char*)d_ws; a.ph_lo = 0; a.ph_hi = NPHASE;
    hipLaunchKernelGGL(mk_fwd, dim3(grid), dim3(NTHREADS), LDS_BYTES, stream, a);
}
```
